# Optimizing an MI355X kernel written in HIP

```python
import math
import jax
import jax.numpy as jnp
from jax import lax
import numpy as np


D_MODEL = 1024
BATCH = 4
SEQ = 4096
DEPTH = 2

N_ATTN_HEADS = 8
HEAD_DIM = 64
ATTN_WIDTH = N_ATTN_HEADS * HEAD_DIM
LRU_WIDTH = D_MODEL // 2
LRU_BLOCKS = 8
LRU_BLOCK = LRU_WIDTH // LRU_BLOCKS
LRU_CONV = 4
LRU_C = 8.0
CONV_WIDTH = D_MODEL // 2
CONV_KERNEL = 31
MOBA_BLOCK = 256
MOBA_TOPK = 3
MOBA_QCHUNK = 64
IDX_HEADS = 8
IDX_DIM = 64
DSA_TOPK_MAX = 256
DSA_QCHUNK = 128
REL_BUCKETS = 32
REL_MAX_EXACT = REL_BUCKETS // 2
REL_MAX_DIST = 128
D_FF = 2816
EPS = 1e-6
NEG = -1e30
EVEN_SPLITS = (LRU_WIDTH, LRU_WIDTH, ATTN_WIDTH, ATTN_WIDTH, ATTN_WIDTH)
ODD_SPLITS = (2 * CONV_WIDTH, ATTN_WIDTH, ATTN_WIDTH, ATTN_WIDTH, IDX_HEADS * IDX_DIM, IDX_DIM, IDX_HEADS)

kernel_name = 'hybrid_rglru_moba_conformer_dsa_macaron'


def _split(z, sizes):
    idx = list(np.cumsum(sizes)[:-1])
    return jnp.split(z, idx, axis=-1)


def rms_norm(x, g):
    xf = x.astype(jnp.float32)
    y = xf * lax.rsqrt(jnp.mean(xf * xf, axis=-1, keepdims=True) + EPS)
    return (y * g.astype(jnp.float32)).astype(x.dtype)


def layer_norm(x, g, b):
    xf = x.astype(jnp.float32)
    mu = jnp.mean(xf, axis=-1, keepdims=True)
    var = jnp.mean(jnp.square(xf - mu), axis=-1, keepdims=True)
    y = (xf - mu) * lax.rsqrt(var + EPS)
    return (y * g.astype(jnp.float32) + b.astype(jnp.float32)).astype(x.dtype)


def swiglu(x, w_gate, w_up, w_down):
    return (jax.nn.silu(x @ w_gate) * (x @ w_up)) @ w_down


def causal_depthwise_conv(x, w, b):
    width = w.shape[0]
    y = lax.conv_general_dilated(
        x, w[:, None, :].astype(x.dtype), window_strides=(1,), padding=[(width - 1, 0)],
        dimension_numbers=('NWC', 'WIO', 'NWC'), feature_group_count=x.shape[-1])
    return y + b.astype(x.dtype)


def rel_bucket(dist):
    n = jnp.maximum(dist, 0)
    nf = jnp.maximum(n, 1).astype(jnp.float32)
    large = REL_MAX_EXACT + (jnp.log(nf / REL_MAX_EXACT) / math.log(REL_MAX_DIST / REL_MAX_EXACT)
                             * (REL_BUCKETS - REL_MAX_EXACT)).astype(jnp.int32)
    large = jnp.minimum(large, REL_BUCKETS - 1)
    return jnp.where(n < REL_MAX_EXACT, n, large)


def head_rms(x, g):
    return rms_norm(x, g)


def _lru_combine(e1, e2):
    a1, b1 = e1
    a2, b2 = e2
    return a1 * a2, a2 * b1 + b2


def rg_lru(x, w_a, b_a, w_x, b_x, lam):
    bsz, seq, width = x.shape
    xb = x.reshape(bsz, seq, LRU_BLOCKS, LRU_BLOCK)
    r = jax.nn.sigmoid(jnp.einsum('bsgi,gij->bsgj', xb, w_a).reshape(bsz, seq, width) + b_a)
    i = jax.nn.sigmoid(jnp.einsum('bsgi,gij->bsgj', xb, w_x).reshape(bsz, seq, width) + b_x)
    log_a = -LRU_C * r.astype(jnp.float32) * jax.nn.softplus(-lam.astype(jnp.float32))
    a = jnp.exp(log_a)
    mult = jnp.sqrt(-jnp.expm1(2.0 * log_a))
    u = mult * (i * x).astype(jnp.float32)
    _, h = lax.associative_scan(_lru_combine, (a, u), axis=1)
    return h.astype(x.dtype)


def moba_attention(q, k, v, rel_bias):
    bsz, seq, nh, hd = q.shape
    nb = -(-seq // MOBA_BLOCK)
    pad = nb * MOBA_BLOCK - seq
    qh = q.transpose(0, 2, 1, 3)
    kh = jnp.pad(k.transpose(0, 2, 1, 3), ((0, 0), (0, 0), (0, pad), (0, 0)))
    vh = jnp.pad(v.transpose(0, 2, 1, 3), ((0, 0), (0, 0), (0, pad), (0, 0)))
    kblk = kh.reshape(bsz, nh, nb, MOBA_BLOCK, hd)
    vblk = vh.reshape(bsz, nh, nb, MOBA_BLOCK, hd)
    kmean = jnp.mean(kblk.astype(jnp.float32), axis=3).astype(k.dtype)
    topk = min(MOBA_TOPK, nb)
    scale = hd ** -0.5
    bidx = jnp.arange(bsz)[:, None, None, None]
    hidx = jnp.arange(nh)[None, :, None, None]
    h5 = jnp.arange(nh)[None, :, None, None, None]
    offs = jnp.arange(MOBA_BLOCK)
    blk_ids = jnp.arange(nb)

    def chunk(t0):
        qc = lax.dynamic_slice_in_dim(qh, t0, MOBA_QCHUNK, axis=2)
        t = t0 + jnp.arange(MOBA_QCHUNK)
        own = t0 // MOBA_BLOCK
        gate = jnp.einsum('bhcd,bhnd->bhcn', qc, kmean).astype(jnp.float32)
        gate = jnp.where(blk_ids < own, gate, NEG)
        _, sel = lax.top_k(gate, topk)
        valid = jnp.arange(topk) < own
        ksel = kblk[bidx, hidx, sel]
        vsel = vblk[bidx, hidx, sel]
        s_pos = sel[..., None] * MOBA_BLOCK + offs
        lsel = jnp.einsum('bhcd,bhcjsd->bhcjs', qc, ksel).astype(jnp.float32) * scale
        lsel = lsel + rel_bias[rel_bucket(t[None, None, :, None, None] - s_pos), h5].astype(jnp.float32)
        lsel = jnp.where(valid[:, None], lsel, NEG)
        kown = lax.dynamic_slice_in_dim(kh, own * MOBA_BLOCK, MOBA_BLOCK, axis=2)
        vown = lax.dynamic_slice_in_dim(vh, own * MOBA_BLOCK, MOBA_BLOCK, axis=2)
        s_own = own * MOBA_BLOCK + offs
        lown = jnp.einsum('bhcd,bhsd->bhcs', qc, kown).astype(jnp.float32) * scale
        lown = lown + rel_bias[rel_bucket(t[:, None] - s_own[None, :])].transpose(2, 0, 1).astype(jnp.float32)
        lown = jnp.where(s_own[None, :] <= t[:, None], lown, NEG)
        logits = jnp.concatenate([lsel.reshape(bsz, nh, MOBA_QCHUNK, topk * MOBA_BLOCK), lown], axis=-1)
        p = jax.nn.softmax(logits, axis=-1).astype(v.dtype)
        psel = p[..., :topk * MOBA_BLOCK].reshape(bsz, nh, MOBA_QCHUNK, topk, MOBA_BLOCK)
        pown = p[..., topk * MOBA_BLOCK:]
        return (jnp.einsum('bhcjs,bhcjsd->bhcd', psel, vsel)
                + jnp.einsum('bhcs,bhsd->bhcd', pown, vown))

    starts = jnp.arange(seq // MOBA_QCHUNK) * MOBA_QCHUNK
    outs = lax.map(chunk, starts)
    return outs.transpose(1, 0, 3, 2, 4).reshape(bsz, seq, nh * hd)


def dsa_attention(q, k, v, qi, ki, wi, rel_bias):
    bsz, seq, nh, hd = q.shape
    n_sel = min(DSA_TOPK_MAX, seq // 4)
    qchunk = min(DSA_QCHUNK, seq)
    scale = hd ** -0.5
    idx_scale = IDX_DIM ** -0.5 * IDX_HEADS ** -0.5
    bidx = jnp.arange(bsz)[:, None, None]
    key_pos = jnp.arange(seq)

    def chunk(t0):
        t = t0 + jnp.arange(qchunk)
        qic = lax.dynamic_slice_in_dim(qi, t0, qchunk, axis=1)
        wic = lax.dynamic_slice_in_dim(wi, t0, qchunk, axis=1)
        sc = jax.nn.relu(jnp.einsum('bchd,bsd->bchs', qic, ki).astype(jnp.float32))
        isc = jnp.einsum('bchs,bch->bcs', sc, wic.astype(jnp.float32)) * idx_scale
        isc = jnp.where(key_pos[None, None, :] <= t[None, :, None], isc, NEG)
        _, sel = lax.top_k(isc, n_sel)
        valid = sel <= t[None, :, None]
        ksel = k[bidx, sel]
        vsel = v[bidx, sel]
        qc = lax.dynamic_slice_in_dim(q, t0, qchunk, axis=1)
        logit = jnp.einsum('bchd,bckhd->bhck', qc, ksel).astype(jnp.float32) * scale
        bias = rel_bias[rel_bucket(t[None, :, None] - sel)].transpose(0, 3, 1, 2).astype(jnp.float32)
        logit = jnp.where(valid[:, None], logit + bias, NEG)
        p = jax.nn.softmax(logit, axis=-1).astype(v.dtype)
        return jnp.einsum('bhck,bckhd->bchd', p, vsel)

    starts = jnp.arange(seq // qchunk) * qchunk
    outs = lax.map(chunk, starts)
    return outs.transpose(1, 0, 2, 3, 4).reshape(bsz, seq, nh * hd)


def even_mixer(h, w_in, conv_w, conv_b, ra_w, ra_b, ix_w, ix_b, lam, q_norm, k_norm, w_out, rel_bias):
    bsz, seq, _ = h.shape
    gate, xr, q, k, v = _split(h @ w_in, EVEN_SPLITS)
    xr = causal_depthwise_conv(xr, conv_w, conv_b)
    ya = rg_lru(xr, ra_w, ra_b, ix_w, ix_b, lam) * jax.nn.gelu(gate)
    q = head_rms(q.reshape(bsz, seq, N_ATTN_HEADS, HEAD_DIM), q_norm)
    k = head_rms(k.reshape(bsz, seq, N_ATTN_HEADS, HEAD_DIM), k_norm)
    v = v.reshape(bsz, seq, N_ATTN_HEADS, HEAD_DIM)
    yb = moba_attention(q, k, v, rel_bias)
    return jnp.concatenate([ya, yb], axis=-1) @ w_out


def odd_mixer(h, w_in, dw_w, dw_b, ln_g, ln_b, q_norm, k_norm, w_out, rel_bias):
    bsz, seq, _ = h.shape
    glu, q, k, v, qi, ki, wi = _split(h @ w_in, ODD_SPLITS)
    ca, cg = jnp.split(glu, 2, axis=-1)
    c = ca * jax.nn.sigmoid(cg)
    c = causal_depthwise_conv(c, dw_w, dw_b)
    c = jax.nn.silu(layer_norm(c, ln_g, ln_b))
    q = head_rms(q.reshape(bsz, seq, N_ATTN_HEADS, HEAD_DIM), q_norm)
    k = head_rms(k.reshape(bsz, seq, N_ATTN_HEADS, HEAD_DIM), k_norm)
    v = v.reshape(bsz, seq, N_ATTN_HEADS, HEAD_DIM)
    qi = qi.reshape(bsz, seq, IDX_HEADS, IDX_DIM)
    yd = dsa_attention(q, k, v, qi, ki, wi, rel_bias)
    return jnp.concatenate([c, yd], axis=-1) @ w_out


def setup_inputs(seed: int = 0) -> dict:
    key = jax.random.key(seed)
    ks = iter(jax.random.split(key, 40))
    n_even = (DEPTH + 1) // 2
    n_odd = DEPTH // 2

    def nrm(shape, fan_in):
        return jax.random.normal(next(ks), shape, jnp.float32) * fan_in ** -0.5

    def gain(shape):
        return 1.0 + 0.02 * jax.random.normal(next(ks), shape, jnp.float32)

    def bias(shape):
        return 0.01 * jax.random.normal(next(ks), shape, jnp.float32)

    x = jax.random.normal(next(ks), (BATCH, SEQ, D_MODEL), jnp.float32)
    rel_bias = 0.2 * jax.random.normal(next(ks), (REL_BUCKETS, N_ATTN_HEADS), jnp.float32)
    ffn1_norm = gain((DEPTH, D_MODEL))
    ffn1_w_gate = nrm((DEPTH, D_MODEL, D_FF), D_MODEL)
    ffn1_w_up = nrm((DEPTH, D_MODEL, D_FF), D_MODEL)
    ffn1_w_down = nrm((DEPTH, D_FF, D_MODEL), D_FF)
    mix_norm = gain((DEPTH, D_MODEL))
    ffn2_norm = gain((DEPTH, D_MODEL))
    ffn2_w_gate = nrm((DEPTH, D_MODEL, D_FF), D_MODEL)
    ffn2_w_up = nrm((DEPTH, D_MODEL, D_FF), D_MODEL)
    ffn2_w_down = nrm((DEPTH, D_FF, D_MODEL), D_FF)
    ev_w_in = nrm((n_even, D_MODEL, sum(EVEN_SPLITS)), D_MODEL)
    ev_conv_w = nrm((n_even, LRU_CONV, LRU_WIDTH), LRU_CONV)
    ev_conv_b = bias((n_even, LRU_WIDTH))
    ev_ra_w = nrm((n_even, LRU_BLOCKS, LRU_BLOCK, LRU_BLOCK), LRU_BLOCK)
    ev_ra_b = bias((n_even, LRU_WIDTH))
    ev_ix_w = nrm((n_even, LRU_BLOCKS, LRU_BLOCK, LRU_BLOCK), LRU_BLOCK)
    ev_ix_b = bias((n_even, LRU_WIDTH))
    a0 = jax.random.uniform(next(ks), (n_even, LRU_WIDTH), jnp.float32, 0.9, 0.999)
    s = a0 ** (1.0 / LRU_C)
    ev_lambda = jnp.log(s) - jnp.log1p(-s)
    ev_q_norm = gain((n_even, HEAD_DIM))
    ev_k_norm = gain((n_even, HEAD_DIM))
    ev_w_out = nrm((n_even, LRU_WIDTH + ATTN_WIDTH, D_MODEL), LRU_WIDTH + ATTN_WIDTH)
    od_w_in = nrm((n_odd, D_MODEL, sum(ODD_SPLITS)), D_MODEL)
    od_dw_w = nrm((n_odd, CONV_KERNEL, CONV_WIDTH), CONV_KERNEL)
    od_dw_b = bias((n_odd, CONV_WIDTH))
    od_ln_g = gain((n_odd, CONV_WIDTH))
    od_ln_b = bias((n_odd, CONV_WIDTH))
    od_q_norm = gain((n_odd, HEAD_DIM))
    od_k_norm = gain((n_odd, HEAD_DIM))
    od_w_out = nrm((n_odd, CONV_WIDTH + ATTN_WIDTH, D_MODEL), CONV_WIDTH + ATTN_WIDTH)
    return {
        'x': x, 'rel_bias': rel_bias,
        'ffn1_norm': ffn1_norm, 'ffn1_w_gate': ffn1_w_gate, 'ffn1_w_up': ffn1_w_up, 'ffn1_w_down': ffn1_w_down,
        'mix_norm': mix_norm,
        'ffn2_norm': ffn2_norm, 'ffn2_w_gate': ffn2_w_gate, 'ffn2_w_up': ffn2_w_up, 'ffn2_w_down': ffn2_w_down,
        'ev_w_in': ev_w_in, 'ev_conv_w': ev_conv_w, 'ev_conv_b': ev_conv_b, 'ev_ra_w': ev_ra_w, 'ev_ra_b': ev_ra_b,
        'ev_ix_w': ev_ix_w, 'ev_ix_b': ev_ix_b, 'ev_lambda': ev_lambda, 'ev_q_norm': ev_q_norm,
        'ev_k_norm': ev_k_norm, 'ev_w_out': ev_w_out,
        'od_w_in': od_w_in, 'od_dw_w': od_dw_w, 'od_dw_b': od_dw_b, 'od_ln_g': od_ln_g, 'od_ln_b': od_ln_b,
        'od_q_norm': od_q_norm, 'od_k_norm': od_k_norm, 'od_w_out': od_w_out,
    }


def reference(x, rel_bias,
              ffn1_norm, ffn1_w_gate, ffn1_w_up, ffn1_w_down,
              mix_norm,
              ffn2_norm, ffn2_w_gate, ffn2_w_up, ffn2_w_down,
              ev_w_in, ev_conv_w, ev_conv_b, ev_ra_w, ev_ra_b, ev_ix_w, ev_ix_b, ev_lambda,
              ev_q_norm, ev_k_norm, ev_w_out,
              od_w_in, od_dw_w, od_dw_b, od_ln_g, od_ln_b, od_q_norm, od_k_norm, od_w_out):
    for i in range(DEPTH):
        h = rms_norm(x, ffn1_norm[i])
        x = x + 0.5 * swiglu(h, ffn1_w_gate[i], ffn1_w_up[i], ffn1_w_down[i])
        h = rms_norm(x, mix_norm[i])
        j = i // 2
        if i % 2 == 0:
            x = x + even_mixer(h, ev_w_in[j], ev_conv_w[j], ev_conv_b[j], ev_ra_w[j], ev_ra_b[j],
                               ev_ix_w[j], ev_ix_b[j], ev_lambda[j], ev_q_norm[j], ev_k_norm[j],
                               ev_w_out[j], rel_bias)
        else:
            x = x + odd_mixer(h, od_w_in[j], od_dw_w[j], od_dw_b[j], od_ln_g[j], od_ln_b[j],
                              od_q_norm[j], od_k_norm[j], od_w_out[j], rel_bias)
        h = rms_norm(x, ffn2_norm[i])
        x = x + 0.5 * swiglu(h, ffn2_w_gate[i], ffn2_w_up[i], ffn2_w_down[i])
    return x
```

```cpp
#include <hip/hip_runtime.h>
#include <hip/hip_cooperative_groups.h>
#include <cstdio>
#include <cstdint>
#define MK_STOP_AFTER 17
#define MK_COOP 1
#define DUP_KIND -1
#define SEL_DRY_LEVEL 1
#define ATT_DRY_LEVEL 1
#define SEL_PROF 0
#define ATT_PROF 0
#define ATT_QLDS 0
#define GU_PROF 0
#define LRU_DRY_LEVEL 1
namespace cg = cooperative_groups;

namespace pg8 {
#define PG8_LAS __attribute__((address_space(3)))
typedef unsigned short bf16_t;
typedef short bf16x8 __attribute__((ext_vector_type(8)));
typedef float f32x4 __attribute__((ext_vector_type(4)));
typedef unsigned u32x4 __attribute__((ext_vector_type(4)));
constexpr int BM = 256, BK = 64, HALF = 128, HTB = HALF * BK * 2  , STAGE_BYTES = 8 * HTB, NXCD = 8, WGM = 8;

__host__ __device__ __forceinline__ int lds_byte(int r, int c) { const int st = (r >> 4) * 2 + (c >> 5), rr = r & 15, cc = c & 31, ob = rr * 64 + cc * 2; return st * 1024 + (ob ^ (((ob >> 9) & 1) << 5)); }
__host__ __device__ __forceinline__ void stage_rc(int b, int& R, int& C) { const int st = b / 1024, sb = b % 1024, swz = sb ^ (((sb >> 9) & 1) << 5); R = (st >> 1) * 16 + swz / 64; C = (st & 1) * 32 + (swz % 64) / 2; }
__host__ __device__ __forceinline__ int perm32(int rho) { const int n = rho >> 4, i = rho & 15; return 8 * (i >> 2) + 4 * n + (i & 3); }

struct Unit { int pm, pn; };
struct Gemm { const bf16_t* A; const bf16_t* Bt; int M, N, K; };

struct StaticOrder {
    int nM, nN, nwg, G, c;
    __host__ __device__ void init(int M, int N, int G_, int c_) { nM = M / BM; nN = N / BM; nwg = nM * nN; G = G_; c = c_; }
    __host__ __device__ bool next(int i, Unit& u) const {
        const long L = (long)i * G + c; if (L >= nwg) return false;
        int wgid = (int)L; { const int q = nwg / NXCD, r = nwg % NXCD, xcd = wgid % NXCD, off = wgid / NXCD; wgid = (xcd < r ? xcd * (q + 1) : r * (q + 1) + (xcd - r) * q) + off; }
        const int nig = WGM * nN, gid = wgid / nig, fm = gid * WGM, gsz = (nM - fm) < WGM ? (nM - fm) : WGM;
        u.pm = fm + ((wgid % nig) % gsz); u.pn = (wgid % nig) / gsz; return true;
    }
    __device__ __forceinline__ void a_ready(const Unit&) const {}
    __device__ __forceinline__ void done(const Unit&) const {}
};


__device__ __forceinline__ unsigned cvt_pk_bf16(float lo, float hi) { unsigned r; asm volatile("v_cvt_pk_bf16_f32 %0, %1, %2" : "=v"(r) : "v"(lo), "v"(hi)); return r; }
constexpr float RS_FIX = 16777216.0f, RS_INV = 1.0f / (16777216.0f * 1024.0f), NORM_EPS = 1e-6f;
__device__ __forceinline__ float rstd_of(const unsigned long long* rs, int row) { return __builtin_amdgcn_rsqf((float)rs[row] * RS_INV + NORM_EPS); }
__device__ __forceinline__ float rstd_from(unsigned long long v) { return __builtin_amdgcn_rsqf((float)v * RS_INV + NORM_EPS); }
__device__ __forceinline__ void pre_rows(const unsigned long long* rs, const Unit& u, int wr, int fr, unsigned long long (&pre)[8]) {
    const int row0 = u.pm * BM + wr * 64 + fr;
#pragma unroll
    for (int i = 0; i < 8; ++i) pre[i] = rs[row0 + (i >> 2) * HALF + (i & 3) * 16];
}
__device__ __forceinline__ float sigmoid_f(float x) { return __builtin_amdgcn_rcpf(1.0f + __expf(-x)); }
__device__ __forceinline__ float gelu_tanh_f(float x) { const float z = 0.7978845608028654f * (x + 0.044715f * x * x * x); return x * __builtin_amdgcn_rcpf(1.0f + __expf(-2.0f * z)); }
__device__ __forceinline__ u32x4 pack8(const f32x4 a, const f32x4 b) { u32x4 w; w.x = cvt_pk_bf16(a[0], a[1]); w.y = cvt_pk_bf16(a[2], a[3]); w.z = cvt_pk_bf16(b[0], b[1]); w.w = cvt_pk_bf16(b[2], b[3]); return w; }

struct EpiGU {
    static constexpr bool PERM = true, AFTER_DRAIN = false;
    bf16_t* H; int ldh; const unsigned long long* rs; int dry;
    __device__ __forceinline__ void pre(const Unit& u, int wr, int fr, unsigned long long (&p)[8]) const { pre_rows(rs, u, wr, fr, p); }
    __device__ __forceinline__ void operator()(const f32x4 (&acc)[2][2][4][2], const Unit& u, int wr, int wc, int fr, int fq, const unsigned long long (&pre)[8]) const {
#ifndef GU_PROF
#define GU_PROF 0
#endif
        if (dry && GU_PROF == 1) return;
        const int row0 = u.pm * BM + wr * 64 + fr, col0 = u.pn * HALF + wc * 32 + 8 * fq;
#pragma unroll
        for (int ai = 0; ai < 2; ++ai)
#pragma unroll
            for (int m = 0; m < 4; ++m) { const int row = row0 + ai * HALF + m * 16; const float rstd = rstd_from(pre[ai * 4 + m]);
                f32x4 o[2];
#pragma unroll
                for (int n = 0; n < 2; ++n) { const f32x4 g = acc[ai][0][m][n] * rstd, up = acc[ai][1][m][n] * rstd;
#pragma unroll
                    for (int e = 0; e < 4; ++e) o[n][e] = g[e] * sigmoid_f(g[e]) * up[e]; }
                const u32x4 hv = pack8(o[0], o[1]); if (!dry) *(u32x4*)(H + (size_t)row * ldh + col0) = hv; }
    }
};

struct EpiRes {
    static constexpr bool PERM = true, AFTER_DRAIN = true;
    bf16_t* xb; float* out; unsigned long long* rs; float alpha; int dry;
    __device__ __forceinline__ void pre(const Unit&, int, int, unsigned long long (&)[8]) const {}
    __device__ __forceinline__ void fused(const f32x4 (&acc)[2][2][4][2], const Unit& u, int wr, int wc, int fr, int fq, PG8_LAS unsigned char*, int, int) const {
        const int row0 = u.pm * BM + wr * 64 + fr, col0 = u.pn * BM + wc * 32 + 8 * fq;
#pragma unroll
        for (int ai = 0; ai < 2; ++ai) {
            u32x4 bw[4][2];
#pragma unroll
            for (int m = 0; m < 4; ++m)
#pragma unroll
                for (int bj = 0; bj < 2; ++bj) bw[m][bj] = *(const u32x4*)(xb + (size_t)(row0 + ai * HALF + m * 16) * 1024 + col0 + bj * HALF);
#pragma unroll
            for (int m = 0; m < 4; ++m) { const int row = row0 + ai * HALF + m * 16; float ss = 0.f;
#pragma unroll
                for (int bj = 0; bj < 2; ++bj) { const size_t off = (size_t)row * 1024 + col0 + bj * HALF; const u32x4 w = bw[m][bj];
                    const f32x4 b0 = {__uint_as_float(w.x << 16), __uint_as_float(w.x & 0xffff0000u), __uint_as_float(w.y << 16), __uint_as_float(w.y & 0xffff0000u)};
                    const f32x4 b1 = {__uint_as_float(w.z << 16), __uint_as_float(w.z & 0xffff0000u), __uint_as_float(w.w << 16), __uint_as_float(w.w & 0xffff0000u)};
                    const f32x4 v0 = b0 + acc[ai][bj][m][0] * alpha, v1 = b1 + acc[ai][bj][m][1] * alpha;
                    if (!dry) { if (out) { *(f32x4*)(out + off) = v0; *(f32x4*)(out + off + 4) = v1; } else *(u32x4*)(xb + off) = pack8(v0, v1); }
                    ss += (v0[0] * v0[0] + v0[1] * v0[1]) + (v0[2] * v0[2] + v0[3] * v0[3]) + (v1[0] * v1[0] + v1[1] * v1[1]) + (v1[2] * v1[2] + v1[3] * v1[3]); }
                if (rs && !dry) { ss += __shfl_xor(ss, 16); ss += __shfl_xor(ss, 32);
                    if (fq == 0) atomicAdd(rs + row, (unsigned long long)(ss * RS_FIX)); } }
            asm volatile("" ::: "memory"); }
    }
};

struct TileDesc { int kind; int idx; bf16_t* P; int ld; const float* gain; float scale; };
struct EpiMix {
    static constexpr bool PERM = true, AFTER_DRAIN = false;
    const unsigned long long* rs; int odd; bf16_t *Y, *XR, *K, *V, *QI, *KI; const float *qg, *kg; float qscale; float* WI; float wscale;
    __device__ __forceinline__ TileDesc desc(int pn) const {
        TileDesc t; t.gain = nullptr; t.scale = 1.f;
        if (!odd) {
            if (pn < 2) { t.kind = 0; t.idx = pn; t.P = Y; t.ld = 1024; }
            else if (pn < 4) { t.kind = 1; t.idx = pn - 2; t.P = XR; t.ld = 512; }
            else if (pn < 6) { t.kind = 2; t.idx = pn - 4; t.P = Y + 512; t.ld = 1024; t.gain = qg; t.scale = qscale; }
            else if (pn < 8) { t.kind = 2; t.idx = pn - 6; t.P = K; t.ld = 512; t.gain = kg; }
            else { t.kind = 1; t.idx = pn - 8; t.P = V; t.ld = 512; }
        } else {
            if (pn < 4) { t.kind = 3; t.idx = pn; t.P = XR; t.ld = 512; }
            else if (pn < 6) { t.kind = 2; t.idx = pn - 4; t.P = Y + 512; t.ld = 1024; t.gain = qg; t.scale = qscale; }
            else if (pn < 8) { t.kind = 2; t.idx = pn - 6; t.P = K; t.ld = 512; t.gain = kg; }
            else if (pn < 10) { t.kind = 1; t.idx = pn - 8; t.P = V; t.ld = 512; }
            else if (pn < 12) { t.kind = 1; t.idx = pn - 10; t.P = QI; t.ld = 512; }
            else { t.kind = 4; t.idx = 0; t.P = KI; t.ld = 64; }
        }
        return t;
    }
    __device__ __forceinline__ void pre(const Unit& u, int wr, int fr, unsigned long long (&p)[8]) const { pre_rows(rs, u, wr, fr, p); }
    __device__ __forceinline__ void operator()(const f32x4 (&acc)[2][2][4][2], const Unit& u, int wr, int wc, int fr, int fq, const unsigned long long (&pre)[8]) const {
        const TileDesc t = desc(u.pn);
        const int row0 = u.pm * BM + wr * 64 + fr;
        if (t.kind == 0 || t.kind == 1) {
#pragma unroll
            for (int ai = 0; ai < 2; ++ai)
#pragma unroll
                for (int m = 0; m < 4; ++m) { const int row = row0 + ai * HALF + m * 16; const float rstd = rstd_from(pre[ai * 4 + m]);
#pragma unroll
                    for (int bj = 0; bj < 2; ++bj) { f32x4 v0 = acc[ai][bj][m][0] * rstd, v1 = acc[ai][bj][m][1] * rstd;
                        if (t.kind == 0) {
#pragma unroll
                            for (int e = 0; e < 4; ++e) { v0[e] = gelu_tanh_f(v0[e]); v1[e] = gelu_tanh_f(v1[e]); } }
                        *(u32x4*)(t.P + (size_t)row * t.ld + t.idx * 256 + bj * HALF + wc * 32 + 8 * fq) = pack8(v0, v1); } }
        } else if (t.kind == 2) {
            float gn[2][2][4];
#pragma unroll
            for (int bj = 0; bj < 2; ++bj)
#pragma unroll
                for (int n = 0; n < 2; ++n)
#pragma unroll
                    for (int e = 0; e < 4; ++e) gn[bj][n][e] = t.gain[32 * bj + 8 * fq + 4 * n + e] * t.scale;
#pragma unroll
            for (int ai = 0; ai < 2; ++ai)
#pragma unroll
                for (int m = 0; m < 4; ++m) { const int row = row0 + ai * HALF + m * 16; const float rstd = rstd_from(pre[ai * 4 + m]);
                    f32x4 v[2][2]; float ss = 0.f;
#pragma unroll
                    for (int bj = 0; bj < 2; ++bj)
#pragma unroll
                        for (int n = 0; n < 2; ++n) { v[bj][n] = acc[ai][bj][m][n] * rstd; ss += (v[bj][n][0] * v[bj][n][0] + v[bj][n][1] * v[bj][n][1]) + (v[bj][n][2] * v[bj][n][2] + v[bj][n][3] * v[bj][n][3]); }
                    ss += __shfl_xor(ss, 16); ss += __shfl_xor(ss, 32);
                    const float hr = __builtin_amdgcn_rsqf(ss * (1.0f / 64.0f) + NORM_EPS);
#pragma unroll
                    for (int bj = 0; bj < 2; ++bj) {
#pragma unroll
                        for (int n = 0; n < 2; ++n)
#pragma unroll
                            for (int e = 0; e < 4; ++e) v[bj][n][e] = v[bj][n][e] * hr * gn[bj][n][e];
                        *(u32x4*)(t.P + (size_t)row * t.ld + t.idx * 256 + wc * 64 + 32 * bj + 8 * fq) = pack8(v[bj][0], v[bj][1]); } }
        } else if (t.kind == 3) {
#pragma unroll
            for (int ai = 0; ai < 2; ++ai)
#pragma unroll
                for (int m = 0; m < 4; ++m) { const int row = row0 + ai * HALF + m * 16; const float rstd = rstd_from(pre[ai * 4 + m]);
                    f32x4 o[2];
#pragma unroll
                    for (int n = 0; n < 2; ++n) { const f32x4 a = acc[ai][0][m][n] * rstd, g = acc[ai][1][m][n] * rstd;
#pragma unroll
                        for (int e = 0; e < 4; ++e) o[n][e] = a[e] * sigmoid_f(g[e]); }
                    *(u32x4*)(t.P + (size_t)row * t.ld + t.idx * HALF + wc * 32 + 8 * fq) = pack8(o[0], o[1]); }
        } else {
#pragma unroll
            for (int ai = 0; ai < 2; ++ai)
#pragma unroll
                for (int m = 0; m < 4; ++m) { const int row = row0 + ai * HALF + m * 16; const float rstd = rstd_from(pre[ai * 4 + m]);
                    const f32x4 v0 = acc[ai][0][m][0] * rstd, v1 = acc[ai][0][m][1] * rstd;
                    if (wc < 2) *(u32x4*)(t.P + (size_t)row * 64 + wc * 32 + 8 * fq) = pack8(v0, v1);
                    else if (wc == 2 && fq == 0) { *(f32x4*)(WI + (size_t)row * 8) = v0 * wscale; *(f32x4*)(WI + (size_t)row * 8 + 4) = v1 * wscale; } }
        }
    }
};

template <class Epi, class Sched, bool ALIGN_EPI = false, bool SP2 = false>
__device__ __forceinline__ void gemm_phase(PG8_LAS unsigned char* lds, const Gemm g, const Sched& S, const Epi& E, int tid_in) {
    int tid_ = tid_in; asm volatile("" : "+v"(tid_));
    const int tid = tid_, wid = __builtin_amdgcn_readfirstlane(tid >> 6), lane = tid & 63, wr = wid >> 2, wc = wid & 3, fr = lane & 15, fq = lane >> 4;
    const int K = g.K, nt = K / BK;
    unsigned voffA[2], voffB[2];
#pragma unroll
    for (int i = 0; i < 2; ++i) { int R, C; stage_rc(tid * 16 + i * 8192, R, C); const int Rb = Epi::PERM ? ((R & ~31) + perm32(R & 31)) : R;
        voffA[i] = (unsigned)(R * K + C) * 2u; voffB[i] = (unsigned)(Rb * K + C) * 2u; }
    const size_t kstep = (size_t)(BK * 2);
    const size_t hstep = (size_t)HALF * K * 2;
    const size_t tstep = 2 * hstep;
    const unsigned ldsw = (unsigned)wid * 1024u;
    const int aoff = lds_byte(wr * 64 + fr, fq * 8), boff = lds_byte(wc * 32 + fr, fq * 8);
#define PG8_SA(b, h) (((b) * 2 + (h)) * HTB)
#define PG8_SB(b, h) ((4 + (b) * 2 + (h)) * HTB)
#define PG8_STAGE(bufoff, gbase, voff) do { _Pragma("unroll") for (int _i = 0; _i < 2; ++_i) \
        __builtin_amdgcn_global_load_lds((const unsigned*)((const char*)(gbase) + (voff)[_i]), (PG8_LAS unsigned*)(lds + (bufoff) + ldsw + _i * 8192), 16, 0, 0); } while (0)
#define PG8_LDA(dst, b, h) do { _Pragma("unroll") for (int m = 0; m < 4; ++m) _Pragma("unroll") for (int k = 0; k < 2; ++k) dst[m][k] = *(const PG8_LAS bf16x8*)(lds + PG8_SA(b, h) + aoff + m * 2048 + k * 1024); } while (0)
#define PG8_LDB(dst, b, h) do { _Pragma("unroll") for (int n = 0; n < 2; ++n) _Pragma("unroll") for (int k = 0; k < 2; ++k) dst[n][k] = *(const PG8_LAS bf16x8*)(lds + PG8_SB(b, h) + boff + n * 2048 + k * 1024); } while (0)
#define PG8_MMA(ai, bj, At, Bt) do { __builtin_amdgcn_s_setprio(1); _Pragma("unroll") for (int m = 0; m < 4; ++m) _Pragma("unroll") for (int n = 0; n < 2; ++n) _Pragma("unroll") for (int k = 0; k < 2; ++k) \
        acc[ai][bj][m][n] = __builtin_amdgcn_mfma_f32_16x16x32_bf16(Bt[n][k], At[m][k], acc[ai][bj][m][n], 0, 0, 0); __builtin_amdgcn_s_setprio(0); } while (0)
#define PG8_WAIT_V(n) asm volatile("s_waitcnt vmcnt(" #n ")" ::: "memory")
#define PG8_WAIT_L(n) asm volatile("s_waitcnt lgkmcnt(" #n ")" ::: "memory")
#define PG8_BAR __builtin_amdgcn_s_barrier()
#define PG8_SCHED __builtin_amdgcn_sched_barrier(0)
    Unit cur, nxt; int ui = 0;
    if (!S.next(0, cur)) return;
    unsigned long long pre[8];
    E.pre(cur, wr, fr, pre);
    f32x4 acc[2][2][4][2];
#pragma unroll
    for (int a = 0; a < 2; ++a)
#pragma unroll
        for (int b = 0; b < 2; ++b)
#pragma unroll
            for (int m = 0; m < 4; ++m)
#pragma unroll
                for (int n = 0; n < 2; ++n) acc[a][b][m][n] = (f32x4){0.f, 0.f, 0.f, 0.f};
    bf16x8 At[4][2], B0[2][2], B1[2][2];
    const char* cA = (const char*)g.A + (size_t)cur.pm * tstep; const char* cB = (const char*)g.Bt + (size_t)cur.pn * tstep;
    S.a_ready(cur);
    if constexpr (SP2) {
        PG8_STAGE(PG8_SB(0, 0), cB, voffB); PG8_STAGE(PG8_SB(0, 1), cB + hstep, voffB); PG8_STAGE(PG8_SA(0, 0), cA, voffA); PG8_STAGE(PG8_SA(0, 1), cA + hstep, voffA);
        if (wr == 1) PG8_BAR;
        PG8_WAIT_V(2); PG8_BAR;
        PG8_STAGE(PG8_SB(1, 0), cB + kstep, voffB); PG8_STAGE(PG8_SA(1, 0), cA + kstep, voffA); PG8_STAGE(PG8_SB(1, 1), cB + hstep + kstep, voffB);
        PG8_WAIT_V(6); PG8_BAR;
    } else {
        PG8_STAGE(PG8_SB(0, 0), cB, voffB); PG8_STAGE(PG8_SA(0, 0), cA, voffA); PG8_STAGE(PG8_SB(0, 1), cB + hstep, voffB); PG8_STAGE(PG8_SA(0, 1), cA + hstep, voffA);
        if (wr == 1) PG8_BAR;
        PG8_WAIT_V(4); PG8_BAR;
        PG8_STAGE(PG8_SB(1, 0), cB + kstep, voffB); PG8_STAGE(PG8_SA(1, 0), cA + kstep, voffA); PG8_STAGE(PG8_SB(1, 1), cB + hstep + kstep, voffB);
        PG8_WAIT_V(6); PG8_BAR;
    }
    for (;;) {
        const bool has_next = S.next(ui + 1, nxt);
        const char* nA = has_next ? (const char*)g.A + (size_t)nxt.pm * tstep : cA; const char* nB = has_next ? (const char*)g.Bt + (size_t)nxt.pn * tstep : cB;
        for (int t = 0; t < nt; t += 2) {
            const bool last = (t == nt - 2);
            const char* a1 = cA + (size_t)(t + 1) * kstep;
            const char* a2 = last ? nA : cA + (size_t)(t + 2) * kstep; const char* b2 = last ? nB : cB + (size_t)(t + 2) * kstep;
            const char* a3 = a2 + kstep; const char* b3 = b2 + kstep;
            if (last && has_next) S.a_ready(nxt);
            if constexpr (SP2) {
            PG8_LDB(B0, 0, 0); PG8_LDB(B1, 0, 1); PG8_SCHED; PG8_LDA(At, 0, 0); PG8_STAGE(PG8_SA(1, 1), a1 + hstep, voffA);
            PG8_WAIT_V(8); PG8_WAIT_L(0); PG8_BAR; PG8_MMA(0, 0, At, B0); PG8_MMA(0, 1, At, B1); PG8_BAR; PG8_SCHED;
            PG8_LDA(At, 0, 1); PG8_STAGE(PG8_SB(0, 0), b2, voffB); PG8_STAGE(PG8_SB(0, 1), b2 + hstep, voffB); PG8_STAGE(PG8_SA(0, 0), a2, voffA);
            PG8_WAIT_V(8); PG8_WAIT_L(0); PG8_BAR; PG8_MMA(1, 0, At, B0); PG8_MMA(1, 1, At, B1); PG8_BAR; PG8_SCHED;
            PG8_LDB(B0, 1, 0); PG8_LDB(B1, 1, 1); PG8_SCHED; PG8_LDA(At, 1, 0); PG8_STAGE(PG8_SA(0, 1), a2 + hstep, voffA);
            PG8_WAIT_V(8); PG8_WAIT_L(0); PG8_BAR; PG8_MMA(0, 0, At, B0); PG8_MMA(0, 1, At, B1); PG8_BAR; PG8_SCHED;
            PG8_LDA(At, 1, 1); PG8_STAGE(PG8_SB(1, 0), b3, voffB); PG8_STAGE(PG8_SB(1, 1), b3 + hstep, voffB); PG8_STAGE(PG8_SA(1, 0), a3, voffA);
            PG8_WAIT_V(8); PG8_WAIT_L(0); PG8_BAR; PG8_MMA(1, 0, At, B0); PG8_MMA(1, 1, At, B1); PG8_BAR; PG8_SCHED;
            } else {
            PG8_LDB(B0, 0, 0); PG8_SCHED; PG8_LDA(At, 0, 0); PG8_STAGE(PG8_SA(1, 1), a1 + hstep, voffA);
            PG8_WAIT_L(8); PG8_BAR; PG8_WAIT_L(0); PG8_MMA(0, 0, At, B0); PG8_BAR; PG8_SCHED;
            PG8_LDB(B1, 0, 1); PG8_STAGE(PG8_SB(0, 0), b2, voffB);
            PG8_BAR; PG8_WAIT_L(0); PG8_MMA(0, 1, At, B1); PG8_BAR;
            PG8_LDA(At, 0, 1); PG8_STAGE(PG8_SA(0, 0), a2, voffA);
            PG8_BAR; PG8_WAIT_L(0); PG8_MMA(1, 0, At, B0); PG8_BAR; PG8_SCHED;
            PG8_STAGE(PG8_SB(0, 1), b2 + hstep, voffB);
            PG8_WAIT_V(6); PG8_BAR; PG8_MMA(1, 1, At, B1); PG8_BAR;
            PG8_LDB(B0, 1, 0); PG8_SCHED; PG8_LDA(At, 1, 0); PG8_STAGE(PG8_SA(0, 1), a2 + hstep, voffA);
            PG8_WAIT_L(8); PG8_BAR; PG8_WAIT_L(0); PG8_MMA(0, 0, At, B0); PG8_BAR; PG8_SCHED;
            PG8_LDB(B1, 1, 1); PG8_STAGE(PG8_SB(1, 0), b3, voffB);
            PG8_BAR; PG8_WAIT_L(0); PG8_MMA(0, 1, At, B1); PG8_BAR;
            PG8_LDA(At, 1, 1); PG8_STAGE(PG8_SA(1, 0), a3, voffA);
            PG8_BAR; PG8_WAIT_L(0); PG8_MMA(1, 0, At, B0); PG8_BAR; PG8_SCHED;
            PG8_STAGE(PG8_SB(1, 1), b3 + hstep, voffB);
            PG8_WAIT_V(6); PG8_BAR; PG8_MMA(1, 1, At, B1); PG8_BAR;
            }
        }
        if constexpr (ALIGN_EPI) { if (wr == 0) PG8_BAR; }
        if constexpr (!Epi::AFTER_DRAIN) { E(acc, cur, wr, wc, fr, fq, pre); S.done(cur); }
        if (!has_next) break;
#pragma unroll
        for (int a = 0; a < 2; ++a)
#pragma unroll
            for (int b = 0; b < 2; ++b)
#pragma unroll
                for (int m = 0; m < 4; ++m)
#pragma unroll
                    for (int n = 0; n < 2; ++n) acc[a][b][m][n] = (f32x4){0.f, 0.f, 0.f, 0.f};
        cur = nxt; cA = nA; cB = nB; ++ui;
        E.pre(cur, wr, fr, pre);
        if constexpr (ALIGN_EPI) { if (wr == 1) PG8_BAR; }
    }
    PG8_WAIT_V(0);
    if constexpr (!ALIGN_EPI) { if (wr == 0) PG8_BAR; }
    PG8_BAR;
    if constexpr (Epi::AFTER_DRAIN) { E.fused(acc, cur, wr, wc, fr, fq, lds, wid, lane); S.done(cur); }
#undef PG8_SA
#undef PG8_SB
#undef PG8_STAGE
#undef PG8_LDA
#undef PG8_LDB
#undef PG8_MMA
#undef PG8_WAIT_V
#undef PG8_WAIT_L
#undef PG8_BAR
#undef PG8_SCHED
}
}

constexpr int NB = 4, SEQ = 4096, DM = 1024, MT = NB * SEQ, FF = 2816;
constexpr int NH = 8, HD = 64, NBLK = SEQ / 256;
constexpr float LOG2E = 1.4426950408889634f, NEGF = -1e30f;
constexpr float QSCALE = 0.125f * LOG2E;
constexpr float IDX_SCALE = 0.125f * 0.35355339059327373f;
constexpr int NWAVES = 8, NTHR = 512;

constexpr size_t MiB = 1u << 20;
constexpr size_t WS_CTL = 0, CTL_ZERO_BYTES = 1 * MiB;
constexpr size_t WS_RS = 64 * 1024;
constexpr size_t WS_KMEAN = 1 * MiB;
constexpr size_t WS_LSUM = 1 * MiB + 256 * 1024;
constexpr size_t WS_W = 4 * MiB;
constexpr size_t SZ_GU = (size_t)5632 * 1024 * 2, SZ_DN = (size_t)1024 * 2816 * 2;
constexpr size_t WS_GU0 = WS_W, WS_DN0 = WS_GU0 + 4 * SZ_GU, WS_WIN0 = WS_DN0 + 4 * SZ_DN, WS_WIN1 = WS_WIN0 + (size_t)2560 * 1024 * 2,
                 WS_WOUT0 = WS_WIN1 + (size_t)3328 * 1024 * 2, WS_WOUT1 = WS_WOUT0 + 2 * MiB, WS_WEND = WS_WOUT1 + 2 * MiB;
static_assert(WS_WEND <= 86 * MiB, "weights");
constexpr size_t WS_XB = 86 * MiB;
constexpr size_t WS_H = 118 * MiB;
constexpr size_t WS_Y = 118 * MiB, WS_K = 150 * MiB, WS_V = 166 * MiB, WS_XR = 182 * MiB, WS_QI = 198 * MiB, WS_KI = 214 * MiB, WS_WI = 216 * MiB, WS_MASK = 217 * MiB, WS_END = 225 * MiB;

constexpr int LDS_BYTES = 147456;

typedef unsigned short bf16;
typedef float f32x4 __attribute__((ext_vector_type(4)));
typedef float f32x2 __attribute__((ext_vector_type(2)));
typedef float f32x16 __attribute__((ext_vector_type(16)));
typedef unsigned u32x4 __attribute__((ext_vector_type(4)));
typedef unsigned u32x2 __attribute__((ext_vector_type(2)));
typedef short bf16x8 __attribute__((ext_vector_type(8)));
typedef short bf16x4 __attribute__((ext_vector_type(4)));

__device__ __forceinline__ float bf2f(unsigned short v) { return __uint_as_float((unsigned)v << 16); }
__device__ __forceinline__ float bflo(unsigned v) { return __uint_as_float(v << 16); }
__device__ __forceinline__ float bfhi(unsigned v) { return __uint_as_float(v & 0xffff0000u); }
__device__ __forceinline__ unsigned f2bf(float f) { unsigned u = __float_as_uint(f); return (u + 0x7fffu + ((u >> 16) & 1u)) >> 16; }
__device__ __forceinline__ unsigned pk2(float lo, float hi) { return pg8::cvt_pk_bf16(lo, hi); }
__device__ __forceinline__ float wave_sum(float v) {
#pragma unroll
    for (int o = 1; o < 64; o <<= 1) v += __shfl_xor(v, o);
    return v;
}
__device__ __forceinline__ int crow(int r, int hi) { return (r & 3) + 8 * (r >> 2) + 4 * hi; }

struct Args { const float* in[30]; float* out; unsigned char* ws; int ph_lo, ph_hi, coop, pad; };

#define GASP __attribute__((address_space(1)))
struct Frame {
    unsigned char* lds; int tid, lane, wave, G, bid;
    unsigned char* ws; const float* const* in; float* out;
    __device__ __forceinline__ const float* inp(int i) const { return (const float*)(GASP const float*)in[i]; }
};

struct WSrc { const float* W; int ldw; int col0; int ncols; const float* gain; };
__device__ __forceinline__ WSrc src_group(const float* const* in_, int mat, int grp) {
    auto in = [&](int i) -> const float* { return (const float*)(GASP const float*)in_[i]; };
    WSrc s; s.ncols = 32; s.gain = nullptr;
    if (mat < 4) { const int l = mat >> 1, f = mat & 1; const int t = grp >> 3, gg = grp & 7, bj = gg >> 2, x0 = (gg & 3) * 32;
        const float* wg = in(f ? 8 : 3); const float* wu = in(f ? 9 : 4);
        s.W = (bj ? wu : wg) + (size_t)l * 1024 * 2816; s.ldw = 2816; s.col0 = 128 * t + x0; s.gain = in(f ? 7 : 2) + l * 1024; }
    else if (mat < 8) { const int l = (mat - 4) >> 1, f = (mat - 4) & 1; s.W = in(f ? 10 : 5) + (size_t)l * 2816 * 1024; s.ldw = 1024; s.col0 = grp * 32; }
    else if (mat == 8) { const int t = grp >> 3, gg = grp & 7; s.W = in(11); s.ldw = 2560; s.gain = in(6);
        const int ty = t >> 1;
        if (ty == 2 || ty == 3) { const int bj = gg >> 2, wc = gg & 3; s.col0 = 256 * t + 64 * wc + 32 * bj; } else s.col0 = 256 * t + 32 * gg; }
    else if (mat == 9) { const int t = grp >> 3, gg = grp & 7; s.W = in(22); s.ldw = 3144; s.gain = in(6) + 1024;
        if (t < 4) { const int bj = gg >> 2, x0 = (gg & 3) * 32; s.col0 = (bj ? 512 : 0) + 128 * t + x0; }
        else if (t < 8) { const int bj = gg >> 2, wc = gg & 3; s.col0 = 1024 + 256 * (t - 4) + 64 * wc + 32 * bj; }
        else if (t < 12) s.col0 = 2048 + 256 * (t - 8) + 32 * gg;
        else { s.col0 = 3072 + 32 * gg; s.ncols = gg < 2 ? 32 : (gg == 2 ? 8 : 0); } }
    else if (mat == 10) { s.W = in(21); s.ldw = 1024; s.col0 = grp * 32; }
    else { s.W = in(29); s.ldw = 1024; s.col0 = grp * 32; }
    return s;
}
__device__ __forceinline__ void p0_item(const WSrc s0, const WSrc s1, int K, bf16* WT, int grp64, int kb, float* scr, int lane) {
    const int k0 = 64 * kb; const int kq = lane >> 4, nc = lane & 15, half = nc >> 3, cin = 4 * (nc & 7);
    const int col = (half ? s1.col0 : s0.col0) + cin; const bool ok = cin < (half ? s1.ncols : s0.ncols);
    const float* wp = s0.W + (size_t)(k0 + kq) * s0.ldw + col; const float* gp = s0.gain ? s0.gain + k0 + kq : nullptr;
#pragma unroll 8
    for (int i = 0; i < 16; ++i) { f32x4 v = {0.f, 0.f, 0.f, 0.f};
        if (ok) { v = *(const f32x4*)(wp + (size_t)(4 * i) * s0.ldw); if (gp) v = v * gp[4 * i]; }
        float* d = scr + (4 * i + kq) * 65 + 4 * nc; d[0] = v.x; d[1] = v.y; d[2] = v.z; d[3] = v.w; }
    asm volatile("s_waitcnt lgkmcnt(0)" ::: "memory");
    const int c = lane & 7, ns = lane >> 3;
#pragma unroll
    for (int j = 0; j < 8; ++j) { const int n = 8 * j + ns; const float* sp = scr + (8 * c) * 65 + n;
        u32x4 o; o.x = pk2(sp[0 * 65], sp[1 * 65]); o.y = pk2(sp[2 * 65], sp[3 * 65]); o.z = pk2(sp[4 * 65], sp[5 * 65]); o.w = pk2(sp[6 * 65], sp[7 * 65]);
        *(u32x4*)(WT + (size_t)(grp64 * 64 + n) * K + k0 + 8 * c) = o; }
    asm volatile("s_waitcnt lgkmcnt(0)" ::: "memory");
}
__device__ __forceinline__ void lru_prep_weights(Frame& F);
constexpr int CV_L0 = 1408 + 1408 + 704 + 704 + 640 + 256, CV_L1 = 1408 + 1408 + 704 + 704 + 832 + 256, CV_ALL = CV_L0 + CV_L1;
constexpr int CV_T0 = CV_L0 + 480, CV_T1 = CV_T0 + 1840, CV_T2 = CV_T1 + 1152;
__device__ __forceinline__ void conv_items(Frame& F, int first, int last, int worker, int nworkers) {
    float* scr = (float*)(F.lds + F.wave * 16640);
    for (int it = first + worker; it < last; it += nworkers) {
        const int l = it >= CV_L0 ? 1 : 0; int r = it - l * CV_L0, mat, K, ngrp; bf16* WT;
        const int nwin = l ? 832 : 640;
        if (r < 2816) { const int f = r / 1408; r -= f * 1408; mat = 2 * l + f; K = 1024; ngrp = 88; WT = (bf16*)(F.ws + WS_GU0 + (size_t)mat * SZ_GU); }
        else if ((r -= 2816) < 1408) { const int f = r / 704; r -= f * 704; mat = 4 + 2 * l + f; K = 2816; ngrp = 16; WT = (bf16*)(F.ws + WS_DN0 + (size_t)(2 * l + f) * SZ_DN); }
        else if ((r -= 1408) < nwin) { mat = 8 + l; K = 1024; ngrp = l ? 52 : 40; WT = (bf16*)(F.ws + (l ? WS_WIN1 : WS_WIN0)); }
        else { r -= nwin; mat = 10 + l; K = 1024; ngrp = 16; WT = (bf16*)(F.ws + (l ? WS_WOUT1 : WS_WOUT0)); }
        const int kb = r / ngrp, grp = r % ngrp;
        p0_item(src_group(F.in, mat, 2 * grp), src_group(F.in, mat, 2 * grp + 1), K, WT, grp, kb, scr, F.lane);
    }
}
__device__ __forceinline__ void p0_prologue(Frame& F) {
    const int gw = F.bid * NWAVES + F.wave, NGW = F.G * NWAVES;
    conv_items(F, 0, F.G == 256 ? CV_T0 : CV_ALL, gw, NGW);
    lru_prep_weights(F);
    const float* x = F.inp(0); bf16* XB = (bf16*)(F.ws + WS_XB); unsigned long long* rs0 = (unsigned long long*)(F.ws + WS_RS);
    for (int m = gw; m < MT; m += NGW) {
        const f32x4* xr = (const f32x4*)(x + (size_t)m * DM) + F.lane; unsigned long long* o8 = (unsigned long long*)(XB + (size_t)m * DM) + F.lane;
        float s = 0.f;
#pragma unroll
        for (int j = 0; j < 4; ++j) { const f32x4 v = xr[64 * j]; s += (v.x * v.x + v.y * v.y) + (v.z * v.z + v.w * v.w);
            o8[64 * j] = (unsigned long long)pk2(v.x, v.y) | ((unsigned long long)pk2(v.z, v.w) << 32); }
        s = wave_sum(s);
        if (F.lane == 0) rs0[m] = (unsigned long long)(s * pg8::RS_FIX);
    }
}

constexpr int XC_PITCH = 520, LRU_GY_OFF = 64 * XC_PITCH * 2;
constexpr size_t WS_WLRU = 2 * MiB + 512 * 1024;
__device__ __forceinline__ void lru_prep_weights(Frame& F) {
    const int gt = F.bid * NTHR + F.tid; if (gt >= 8192) return;
    const int lane = gt & 63, ks = (gt >> 6) & 3, ct = (gt >> 8) & 1, g = (gt >> 9) & 7, mat = gt >> 12, r32 = lane & 31, hi = lane >> 5;
    const float* W = F.inp(mat ? 16 : 14) + (size_t)g * 4096 + (16 * ks + 8 * hi) * 64 + 32 * ct + r32;
    u32x4 o; o.x = pk2(W[0], W[64]); o.y = pk2(W[128], W[192]); o.z = pk2(W[256], W[320]); o.w = pk2(W[384], W[448]);
    *(u32x4*)((bf16*)(F.ws + WS_WLRU) + (size_t)gt * 8) = o;
}
__device__ __forceinline__ void lru_unit(Frame& F, int b, int j, int pass, int dry) {
    typedef short v4i16_t __attribute__((ext_vector_type(4))); typedef __attribute__((address_space(3))) v4i16_t* lds_v4p;
    const int c = F.tid, lane = F.lane, g = F.wave, r32 = lane & 31, hi = lane >> 5;
    const float* conv_w = F.inp(12); const float* conv_b = F.inp(13); const float* ra_b = F.inp(15); const float* ix_b = F.inp(17); const float* lam = F.inp(18);
    const bf16* XR = (const bf16*)(F.ws + WS_XR); bf16* Y = (bf16*)(F.ws + WS_Y); float* LSUM = (float*)(F.ws + WS_LSUM);
    bf16* XC = (bf16*)F.lds; bf16* GY = (bf16*)(F.lds + LRU_GY_OFF);
    const int t0 = j * 64; const size_t row0 = (size_t)b * SEQ + t0;
    { const int cg8 = c & 63, tg = c >> 6, ch0 = cg8 * 8, tb = tg * 8;
      f32x4 w[4][2];
#pragma unroll
      for (int k = 0; k < 4; ++k) { w[k][0] = *(const f32x4*)(conv_w + k * 512 + ch0); w[k][1] = *(const f32x4*)(conv_w + k * 512 + ch0 + 4); }
      const f32x4 cb0 = *(const f32x4*)(conv_b + ch0), cb1 = *(const f32x4*)(conv_b + ch0 + 4);
#pragma unroll 1
      for (int hf = 0; hf < 2; ++hf) { const int tb4 = tb + 4 * hf;
          u32x4 xr[7], gv[4];
#pragma unroll
          for (int i = 0; i < 7; ++i) { const int t = tb4 - 3 + i; xr[i] = (u32x4){0u, 0u, 0u, 0u}; if (t0 + t >= 0) xr[i] = *(const u32x4*)(XR + ((long)row0 + t) * 512 + ch0); }
          if (pass) {
#pragma unroll
              for (int u = 0; u < 4; ++u) { const int i = c + (4 * hf + u) * NTHR; gv[u] = *(const u32x4*)(Y + (row0 + (i >> 6)) * 1024 + (i & 63) * 8); }
#pragma unroll
              for (int u = 0; u < 4; ++u) { const int i = c + (4 * hf + u) * NTHR; *(u32x4*)(GY + (i >> 6) * XC_PITCH + (i & 63) * 8) = gv[u]; } }
#pragma unroll
          for (int tt = 0; tt < 4; ++tt) { f32x4 a0 = cb0, a1 = cb1;
#pragma unroll
              for (int k = 0; k < 4; ++k) { const u32x4 v = xr[tt + k];
                  a0 += w[k][0] * (f32x4){bflo(v.x), bfhi(v.x), bflo(v.y), bfhi(v.y)}; a1 += w[k][1] * (f32x4){bflo(v.z), bfhi(v.z), bflo(v.w), bfhi(v.w)}; }
              *(u32x4*)(XC + (tb4 + tt) * XC_PITCH + ch0) = pg8::pack8(a0, a1); } } }
    __syncthreads();
#ifndef LRU_DRY_LEVEL
#define LRU_DRY_LEVEL 1
#endif
    if (dry && LRU_DRY_LEVEL == 2) { __syncthreads(); return; }
    bf16x8 wfa[2][4], wfx[2][4];
    { const bf16* wl = (const bf16*)(F.ws + WS_WLRU) + (size_t)lane * 8;
#pragma unroll
      for (int ct = 0; ct < 2; ++ct)
#pragma unroll
          for (int ks = 0; ks < 4; ++ks) { wfa[ct][ks] = *(const bf16x8*)(wl + (size_t)(((0 * 8 + g) * 2 + ct) * 4 + ks) * 512); wfx[ct][ks] = *(const bf16x8*)(wl + (size_t)(((1 * 8 + g) * 2 + ct) * 4 + ks) * 512); } }
    float carry[2], aprod[2], ba[2], bx[2], sp8[2];
#pragma unroll
    for (int ct = 0; ct < 2; ++ct) { const int ch = 64 * g + 32 * ct + r32; ba[ct] = ra_b[ch]; bx[ct] = ix_b[ch]; sp8[ct] = -8.0f * log1pf(expf(-lam[ch])); carry[ct] = 0.f; aprod[ct] = 1.f; }
    if (pass) { const float* sm0 = LSUM + ((size_t)b * 64 * 512 + 64 * g + r32) * 2;
        int jj = 0;
        for (; jj + 16 <= j; jj += 16) { f32x2 v0[16], v1[16];
#pragma unroll
            for (int u = 0; u < 16; ++u) { v0[u] = *(const f32x2*)(sm0 + (size_t)(jj + u) * 1024); v1[u] = *(const f32x2*)(sm0 + (size_t)(jj + u) * 1024 + 64); }
#pragma unroll
            for (int u = 0; u < 16; ++u) { carry[0] = v0[u].x * carry[0] + v0[u].y; carry[1] = v1[u].x * carry[1] + v1[u].y; } }
        if (jj < j) { f32x2 v0[16], v1[16];
#pragma unroll
            for (int u = 0; u < 16; ++u) { const int jc = jj + u < j ? jj + u : jj; v0[u] = *(const f32x2*)(sm0 + (size_t)jc * 1024); v1[u] = *(const f32x2*)(sm0 + (size_t)jc * 1024 + 64); }
#pragma unroll
            for (int u = 0; u < 16; ++u) if (jj + u < j) { carry[0] = v0[u].x * carry[0] + v0[u].y; carry[1] = v1[u].x * carry[1] + v1[u].y; } } }
    if (dry && LRU_DRY_LEVEL == 3) { if (carry[0] + carry[1] + ba[0] + sp8[1] == 123.f) XC[0] = 1; __syncthreads(); return; }
#pragma unroll 1
    for (int tt = 0; tt < 2; ++tt) {
#pragma unroll
        for (int ct = 0; ct < 2; ++ct) {
            f32x16 accA = {}, accX = {};
#pragma unroll
            for (int ks = 0; ks < 4; ++ks) { const bf16x8 af = *(const bf16x8*)(XC + (32 * tt + r32) * XC_PITCH + 64 * g + 16 * ks + 8 * hi);
                accA = __builtin_amdgcn_mfma_f32_32x32x16_bf16(af, wfa[ct][ks], accA, 0, 0, 0);
                accX = __builtin_amdgcn_mfma_f32_32x32x16_bf16(af, wfx[ct][ks], accX, 0, 0, 0); }
            const int trow = 32 * tt + 4 * hi + ((lane & 15) >> 2), tcol = 64 * g + 32 * ct + 16 * ((lane >> 4) & 1) + 4 * (lane & 3);
            float av[16], uv[16];
#pragma unroll
            for (int gq = 0; gq < 4; ++gq) {
                const bf16x4 xq = __builtin_bit_cast(bf16x4, __builtin_amdgcn_ds_read_tr16_b64_v4i16((lds_v4p)(XC + (trow + 8 * gq) * XC_PITCH + tcol)));
#pragma unroll
                for (int e = 0; e < 4; ++e) { const int r = 4 * gq + e;
                    const float rr = pg8::sigmoid_f(accA[r] + ba[ct]), ig = pg8::sigmoid_f(accX[r] + bx[ct]);
                    const float la = sp8[ct] * rr, a = __expf(la);
                    const float om = (la > -0.05f) ? -2.0f * la * (1.0f + la * (1.0f + la * 0.6666667f)) : 1.0f - a * a;
                    av[r] = a; uv[r] = sqrtf(om) * ig * bf2f((unsigned short)xq[e]); } }
            float P[4], Sg[4], Pp[4], Sp[4], hin[4];
#pragma unroll
            for (int gq = 0; gq < 4; ++gq) { float p = 1.f, s = 0.f;
#pragma unroll
                for (int e = 0; e < 4; ++e) { s = av[4 * gq + e] * s + uv[4 * gq + e]; p *= av[4 * gq + e]; }
                P[gq] = p; Sg[gq] = s;
                auto r1 = __builtin_amdgcn_permlane32_swap(__float_as_uint(p), __float_as_uint(p), false, false); Pp[gq] = __uint_as_float(hi ? r1[0] : r1[1]);
                auto r2 = __builtin_amdgcn_permlane32_swap(__float_as_uint(s), __float_as_uint(s), false, false); Sp[gq] = __uint_as_float(hi ? r2[0] : r2[1]); }
            float h = carry[ct], ap = aprod[ct];
#pragma unroll
            for (int gq = 0; gq < 4; ++gq) { const float P0 = hi ? Pp[gq] : P[gq], S0 = hi ? Sp[gq] : Sg[gq], P1 = hi ? P[gq] : Pp[gq], S1 = hi ? Sg[gq] : Sp[gq];
                const float h0 = h; h = P0 * h + S0; const float h1 = h; h = P1 * h + S1; hin[gq] = hi ? h1 : h0; ap *= P0 * P1; }
            carry[ct] = h; aprod[ct] = ap;
            if (pass) {
#pragma unroll
                for (int gq = 0; gq < 4; ++gq) { float hh = hin[gq];
                    const bf16x4 gq4 = __builtin_bit_cast(bf16x4, __builtin_amdgcn_ds_read_tr16_b64_v4i16((lds_v4p)(GY + (trow + 8 * gq) * XC_PITCH + tcol)));
#pragma unroll
                    for (int e = 0; e < 4; ++e) { const int r = 4 * gq + e; hh = av[r] * hh + uv[r];
                        GY[(32 * tt + 8 * gq + 4 * hi + e) * XC_PITCH + 64 * g + 32 * ct + r32] = (bf16)f2bf(hh * bf2f((unsigned short)gq4[e])); } } }
        }
    }
    if (!pass) { if (hi == 0 && !dry) {
#pragma unroll
        for (int ct = 0; ct < 2; ++ct) *(f32x2*)(LSUM + (((size_t)b * 64 + j) * 512 + 64 * g + 32 * ct + r32) * 2) = (f32x2){aprod[ct], carry[ct]}; } }
    else { __syncthreads();
        if (!dry) for (int i = c; i < 64 * 64; i += NTHR) { const int r = i >> 6, ch = i & 63; *(u32x4*)(Y + (row0 + r) * 1024 + ch * 8) = *(const u32x4*)(GY + r * XC_PITCH + ch * 8); } }
    __syncthreads();
}

__device__ __forceinline__ void kmean_unit(Frame& F, int b, int blk) {
    const unsigned* K32 = (const unsigned*)(F.ws + WS_K); float* KM = (float*)(F.ws + WS_KMEAN);
    const int cp = F.tid & 255, half = F.tid >> 8; const size_t row0 = (size_t)b * SEQ + blk * 256 + half * 128;
    float s0 = 0.f, s1 = 0.f;
#pragma unroll 8
    for (int r = 0; r < 128; ++r) { const unsigned v = K32[(row0 + r) * 256 + cp]; s0 += bflo(v); s1 += bfhi(v); }
    f32x2* red = (f32x2*)F.lds;
    __syncthreads();
    if (half) red[cp] = (f32x2){s0, s1};
    __syncthreads();
    if (!half) { const f32x2 o = red[cp]; const int col = 2 * cp, hh = col >> 6, d = col & 63;
        *(f32x2*)(KM + (((size_t)b * NH + hh) * 16 + blk) * 64 + d) = (f32x2){(s0 + o.x) * (1.f / 256.f), (s1 + o.y) * (1.f / 256.f)}; }
    __syncthreads();
}

constexpr int KT_PITCH = 72, VT_PITCH = 96;
constexpr int AL_KV = 0, AL_KVBUF = 9216 + 12288, AL_LUT = 3 * AL_KVBUF, AL_KM = AL_LUT + 3072, AL_FLAG = AL_KM + 4096, AL_GATE = AL_FLAG + 64, AL_TL = AL_GATE + 16384, AL_QS = AL_TL + 512, AL_END = AL_QS + 256 * 72 * 2;
__device__ __forceinline__ int rel_bucket(int n) {
    if (n < 16) return n;
    int b = 16;
    b += (n >= 19) + (n >= 21) + (n >= 24) + (n >= 27) + (n >= 31) + (n >= 35) + (n >= 40) + (n >= 46) + (n >= 52) + (n >= 59) + (n >= 67) + (n >= 77) + (n >= 87) + (n >= 99) + (n >= 113);
    return b;
}
__device__ __forceinline__ float max3_f(float a, float b, float c) { float r; asm("v_max3_f32 %0, %1, %2, %3" : "=v"(r) : "v"(a), "v"(b), "v"(c)); return r; }
#ifndef ATT_PROF
#define ATT_PROF 0
#endif
#ifndef ATT_DRY_LEVEL
#define ATT_DRY_LEVEL 1
#endif
template <int MODE  >
__device__ __forceinline__ void attn_unit(Frame& F, int b, int h, int qb, int dry) {
    typedef short v4i16_t __attribute__((ext_vector_type(4))); typedef __attribute__((address_space(3))) v4i16_t* lds_v4p;
    const int tid = F.tid, lane = F.lane, wid = F.wave, r32 = lane & 31, hi = lane >> 5;
    if (dry && ATT_DRY_LEVEL == 5) return;
    const int PROF = (ATT_PROF != 0 && dry) ? ATT_PROF : 0;
    bf16* Y = (bf16*)(F.ws + WS_Y); const bf16* Kg = (const bf16*)(F.ws + WS_K); const bf16* Vg = (const bf16*)(F.ws + WS_V);
    const float* rel_bias = F.inp(1);
    float* lut = (float*)(F.lds + AL_LUT); float* kml = (float*)(F.lds + AL_KM); unsigned* flag = (unsigned*)(F.lds + AL_FLAG); int* tl = (int*)(F.lds + AL_TL);
    const int q0 = qb * 256, wq0 = q0 + wid * 32, tq = wq0 + r32;
    typedef __attribute__((address_space(3))) unsigned short lbf16; typedef __attribute__((address_space(3))) unsigned char lu8;
    lu8* const l3 = (lu8*)F.lds;
    const int vlane = ((4 * hi + ((lane & 15) >> 2)) * VT_PITCH + 16 * ((lane >> 4) & 1) + 4 * (lane & 3)) * 2 + 9216, klane = (r32 * KT_PITCH + 8 * hi) * 2;
    const size_t rowbase = (size_t)b * SEQ;
    const float NINF = -__builtin_inff();
    const float b31 = rel_bias[31 * 8 + h];
    for (int i = tid; i < 768; i += NTHR) { const int dist = i - 256; lut[i] = dist < 0 ? NINF : (rel_bias[rel_bucket(dist) * 8 + h] - b31) * LOG2E; }
    if (MODE == 0) { const float* KM = (const float*)(F.ws + WS_KMEAN) + ((size_t)b * NH + h) * 16 * 64;
        for (int i = tid; i < 1024; i += NTHR) kml[i] = KM[i];
        if (tid < 16) flag[tid] = 0u; }
    bf16x8 qf[4];
    { const bf16* qp = Y + (rowbase + tq) * 1024 + 512 + h * 64 + 8 * hi;
#pragma unroll
      for (int ds = 0; ds < 4; ++ds) qf[ds] = *(const bf16x8*)(qp + 16 * ds); }
#ifndef ATT_QLDS
#define ATT_QLDS 0
#endif
    bf16* qs = (bf16*)(F.lds + AL_QS) + (wid * 32 + r32) * 72 + 8 * hi;
    if (ATT_QLDS) {
#pragma unroll
        for (int ds = 0; ds < 4; ++ds) *(bf16x8*)(qs + 16 * ds) = qf[ds]; }
    const int ldr = tid >> 3, ldc = tid & 7;
    const size_t ldoff = (rowbase + ldr) * 512 + h * 64 + ldc * 8;
    const u32x4 k0r = *(const u32x4*)(Kg + ldoff + (size_t)q0 * 512), v0r = *(const u32x4*)(Vg + ldoff + (size_t)q0 * 512);
    const u32x4 k1r = *(const u32x4*)(Kg + ldoff + (size_t)(q0 + 64) * 512), v1r = *(const u32x4*)(Vg + ldoff + (size_t)(q0 + 64) * 512);
    __syncthreads();
    if (dry && ATT_DRY_LEVEL == 3) { __syncthreads(); return; }
    unsigned selmask = 0u;
    if (MODE == 0) {
        const int own = qb;
        float qv[32];
#pragma unroll
        for (int ds = 0; ds < 4; ++ds)
#pragma unroll
            for (int e = 0; e < 8; ++e) qv[8 * ds + e] = bf2f((unsigned short)qf[ds][e]);
        float g[16];
#pragma unroll
        for (int n = 0; n < 16; ++n) { float s = 0.f;
            if (n < own) {
#pragma unroll
                for (int ds = 0; ds < 4; ++ds) { const f32x4 k0 = *(const f32x4*)(kml + n * 64 + 16 * ds + 8 * hi), k1 = *(const f32x4*)(kml + n * 64 + 16 * ds + 8 * hi + 4);
                    s += qv[8 * ds] * k0.x + qv[8 * ds + 1] * k0.y + qv[8 * ds + 2] * k0.z + qv[8 * ds + 3] * k0.w + qv[8 * ds + 4] * k1.x + qv[8 * ds + 5] * k1.y + qv[8 * ds + 6] * k1.z + qv[8 * ds + 7] * k1.w; }
                auto rr = __builtin_amdgcn_permlane32_swap(__float_as_uint(s), __float_as_uint(s), false, false); s = __uint_as_float(rr[0]) + __uint_as_float(rr[1]); }
            g[n] = s; }
#pragma unroll
        for (int n = 0; n < 16; ++n) { int rank = 0;
#pragma unroll
            for (int m = 0; m < 16; ++m) if (m != n) rank += (m < own && (g[m] > g[n] || (g[m] == g[n] && m < n))) ? 1 : 0;
            if (n < own && rank < 3) selmask |= 1u << n; }
#pragma unroll
        for (int n = 0; n < 16; ++n) if (n < own && __builtin_amdgcn_ballot_w64((selmask >> n) & 1u) != 0ull && lane == 0) atomicOr(&flag[n], 1u);
        __syncthreads();
        if (dry && ATT_DRY_LEVEL == 4) { __syncthreads(); return; }
    }
    if (wid == 0) { const bool f = lane < qb && (MODE == 1 || (lane < 16 && flag[lane & 15] != 0u));
        const unsigned long long bm = __builtin_amdgcn_ballot_w64(f); const int pos = 4 + 4 * __builtin_popcountll(bm & ((1ull << lane) - 1ull));
        if (f) { tl[1 + pos] = lane * 256; tl[2 + pos] = lane * 256 + 64; tl[3 + pos] = lane * 256 + 128; tl[4 + pos] = lane * 256 + 192; }
        if (lane == 0) { tl[0] = 4 + 4 * __builtin_popcountll(bm); tl[1] = q0; tl[2] = q0 + 64; tl[3] = q0 + 128; tl[4] = q0 + 192; } }
    __syncthreads();
    if (dry && ATT_DRY_LEVEL == 2) { __syncthreads(); return; }
    const int nt = tl[0];
    u32x4 kreg, vreg;
#define ATT_FETCH(t) do { const int kv_ = tl[1 + (t)]; kreg = *(const u32x4*)(Kg + ldoff + (size_t)kv_ * 512); vreg = *(const u32x4*)(Vg + ldoff + (size_t)kv_ * 512); } while (0)
#define ATT_STAGE(t) do { bf16* Kn_ = (bf16*)(F.lds + AL_KV + ((t) % 3) * AL_KVBUF); *(u32x4*)(Kn_ + ldr * KT_PITCH + ldc * 8) = kreg; *(u32x4*)(Kn_ + 4608 + ldr * VT_PITCH + ldc * 8) = vreg; } while (0)
    kreg = k0r; vreg = v0r; ATT_STAGE(0); kreg = k1r; vreg = v1r; ATT_STAGE(1);
    ATT_FETCH(2);
    float m_ref = 0.f, l_run = 0.f; f32x16 o0 = {}, o1 = {};
#define ATT_SPLAT(x) (f32x16){x, x, x, x, x, x, x, x, x, x, x, x, x, x, x, x}
    auto tile_flags = [&](int t, bool& sel, unsigned& w0, unsigned& w1) {
        const int kv0 = tl[1 + t], blk = kv0 >> 8; sel = true; w0 = 0xffffffffu; w1 = 0xffffffffu;
        if (MODE == 0) { if (blk < qb) sel = (selmask >> blk) & 1u; }
        else { const u32x2 mw = *(const u32x2*)((const unsigned*)(F.ws + WS_MASK) + (rowbase + tq) * 128 + (kv0 >> 5)); w0 = mw.x; w1 = mw.y; } };
#define ATT_QK(t, S0, S1, SEL) do { const lu8* Kt_ = l3 + AL_KV + ((t) % 3) * AL_KVBUF + klane; asm volatile("" : "+v"(Kt_)); S0 = ATT_SPLAT(0.f); S1 = ATT_SPLAT(0.f); \
        bf16x8 kfr_[8]; \
        _Pragma("unroll") for (int ds = 0; ds < 4; ++ds) { kfr_[2 * ds] = *(const __attribute__((address_space(3))) bf16x8*)(Kt_ + 32 * ds); kfr_[2 * ds + 1] = *(const __attribute__((address_space(3))) bf16x8*)(Kt_ + 32 * KT_PITCH * 2 + 32 * ds); } \
        asm volatile("s_waitcnt lgkmcnt(0)" : "+v"(kfr_[0]), "+v"(kfr_[1]), "+v"(kfr_[2]), "+v"(kfr_[3]), "+v"(kfr_[4]), "+v"(kfr_[5]), "+v"(kfr_[6]), "+v"(kfr_[7]));     \
        _Pragma("unroll") for (int ds = 0; ds < 4; ++ds) { \
            const bf16x8 q_ = ATT_QLDS ? *(const bf16x8*)(qs + 16 * ds) : qf[ds]; \
            S0 = __builtin_amdgcn_mfma_f32_32x32x16_bf16(kfr_[2 * ds], q_, S0, 0, 0, 0); S1 = __builtin_amdgcn_mfma_f32_32x32x16_bf16(kfr_[2 * ds + 1], q_, S1, 0, 0, 0); } \
        asm volatile("s_nop 15\n\ts_nop 7" : "+v"(S0), "+v"(S1)); } while (0)
#define ATT_BIAS(t, S0, S1) do { const int kv_ = tl[1 + (t)]; if (kv_ >= q0 - 256) { const float* lp_ = lut + (tq - kv_ + 256); \
        _Pragma("unroll") for (int r = 0; r < 16; ++r) { const int kr_ = crow(r, hi); S0[r] += lp_[-kr_]; S1[r] += lp_[-kr_ - 32]; } } } while (0)
    auto row_max = [&](bool sel, f32x16& S0, f32x16& S1) -> float {
        float mx = max3_f(S0[0], S0[1], S0[2]);
#pragma unroll
        for (int r = 3; r < 15; r += 2) mx = max3_f(mx, S0[r], S0[r + 1]);
#pragma unroll
        for (int r = 0; r < 16; r += 2) mx = max3_f(mx, S1[r], S1[r + 1]);
        mx = max3_f(mx, S0[15], S0[15]);
        auto rr = __builtin_amdgcn_permlane32_swap(__float_as_uint(mx), __float_as_uint(mx), false, false); return max3_f(__uint_as_float(rr[0]), __uint_as_float(rr[1]), __uint_as_float(rr[1])); };
    f32x16 sc0, sc1, sn0 = {}, sn1 = {};
    bool sel_c, sel_n = true; unsigned mwc0, mwc1, mwn0 = 0u, mwn1 = 0u;
    __syncthreads();
    tile_flags(0, sel_c, mwc0, mwc1);
    { ATT_QK(0, sc0, sc1, sel_c); ATT_BIAS(0, sc0, sc1); const float mx = row_max(sel_c, sc0, sc1);
      if (__builtin_amdgcn_ballot_w64(mx > 8.0f) != 0ull) { const float dl = mx > 0.f ? mx : 0.f; m_ref += dl;
#pragma unroll
          for (int r = 0; r < 16; ++r) { sc0[r] -= dl; sc1[r] -= dl; } } }
#pragma unroll 1
    for (int i = 0; i < nt; ++i) {
        if (PROF != 5) __syncthreads();
        if (PROF != 4 && PROF != 5) { if (i + 2 < nt) { ATT_STAGE(i + 2); if (i + 3 < nt) ATT_FETCH(i + 3); } }
        if (PROF == 6) continue;
        const int tn = i + 1 < nt ? i + 1 : i;
        tile_flags(tn, sel_n, mwn0, mwn1);
        if (PROF != 3) ATT_QK(tn, sn0, sn1, sel_n);
        float ps = 0.f;
#pragma unroll
        for (int r = 0; r < 16; ++r) { float p0 = PROF == 1 ? sc0[r] * 0.5f : __builtin_amdgcn_exp2f(sc0[r]), p1 = PROF == 1 ? sc1[r] * 0.5f : __builtin_amdgcn_exp2f(sc1[r]);
            if (MODE == 1) { const int kr = crow(r, hi);
                p0 = __uint_as_float(__float_as_uint(p0) & (unsigned)__builtin_amdgcn_sbfe((int)mwc0, kr, 1)); p1 = __uint_as_float(__float_as_uint(p1) & (unsigned)__builtin_amdgcn_sbfe((int)mwc1, kr, 1)); }
            sc0[r] = p0; sc1[r] = p1; ps += p0 + p1; }
        u32x4 pw0 = {pk2(sc0[0], sc0[1]), pk2(sc0[2], sc0[3]), pk2(sc0[4], sc0[5]), pk2(sc0[6], sc0[7])};
        u32x4 pw1 = {pk2(sc0[8], sc0[9]), pk2(sc0[10], sc0[11]), pk2(sc0[12], sc0[13]), pk2(sc0[14], sc0[15])};
        u32x4 pw2 = {pk2(sc1[0], sc1[1]), pk2(sc1[2], sc1[3]), pk2(sc1[4], sc1[5]), pk2(sc1[6], sc1[7])};
        u32x4 pw3 = {pk2(sc1[8], sc1[9]), pk2(sc1[10], sc1[11]), pk2(sc1[12], sc1[13]), pk2(sc1[14], sc1[15])};
        if (MODE == 0) { const unsigned sm = sel_c ? 0xffffffffu : 0u; ps = sel_c ? ps : 0.f;
            pw0.x &= sm; pw0.y &= sm; pw0.z &= sm; pw0.w &= sm; pw1.x &= sm; pw1.y &= sm; pw1.z &= sm; pw1.w &= sm;
            pw2.x &= sm; pw2.y &= sm; pw2.z &= sm; pw2.w &= sm; pw3.x &= sm; pw3.y &= sm; pw3.z &= sm; pw3.w &= sm; }
        l_run += ps;
        if (PROF != 3) ATT_BIAS(tn, sn0, sn1);
        if (PROF != 2) { const lu8* vb3 = l3 + AL_KV + (i % 3) * AL_KVBUF + vlane; asm volatile("" : "+v"(vb3));
          bf16x4 vfr[16];
#pragma unroll
          for (int st = 0; st < 4; ++st) { const lu8* vb = vb3 + 16 * st * VT_PITCH * 2;
              vfr[4 * st] = __builtin_bit_cast(bf16x4, __builtin_amdgcn_ds_read_tr16_b64_v4i16((lds_v4p)(vb)));
              vfr[4 * st + 1] = __builtin_bit_cast(bf16x4, __builtin_amdgcn_ds_read_tr16_b64_v4i16((lds_v4p)(vb + 8 * VT_PITCH * 2)));
              vfr[4 * st + 2] = __builtin_bit_cast(bf16x4, __builtin_amdgcn_ds_read_tr16_b64_v4i16((lds_v4p)(vb + 64)));
              vfr[4 * st + 3] = __builtin_bit_cast(bf16x4, __builtin_amdgcn_ds_read_tr16_b64_v4i16((lds_v4p)(vb + 8 * VT_PITCH * 2 + 64))); }
          asm volatile("s_waitcnt lgkmcnt(0)" : "+v"(vfr[0]), "+v"(vfr[1]), "+v"(vfr[2]), "+v"(vfr[3]), "+v"(vfr[4]), "+v"(vfr[5]), "+v"(vfr[6]), "+v"(vfr[7]), "+v"(vfr[8]), "+v"(vfr[9]), "+v"(vfr[10]), "+v"(vfr[11]), "+v"(vfr[12]), "+v"(vfr[13]), "+v"(vfr[14]), "+v"(vfr[15]));
#pragma unroll
          for (int st = 0; st < 4; ++st) { const bf16x8 pf = __builtin_bit_cast(bf16x8, st == 0 ? pw0 : (st == 1 ? pw1 : (st == 2 ? pw2 : pw3)));
              const bf16x4 a0 = vfr[4 * st], a1 = vfr[4 * st + 1], c0 = vfr[4 * st + 2], c1 = vfr[4 * st + 3];
              const bf16x8 vf0 = {a0[0], a0[1], a0[2], a0[3], a1[0], a1[1], a1[2], a1[3]}, vf1 = {c0[0], c0[1], c0[2], c0[3], c1[0], c1[1], c1[2], c1[3]};
              o0 = __builtin_amdgcn_mfma_f32_32x32x16_bf16(vf0, pf, o0, 0, 0, 0);
              o1 = __builtin_amdgcn_mfma_f32_32x32x16_bf16(vf1, pf, o1, 0, 0, 0); } }
        float mxn = PROF == 3 ? 0.f : row_max(sel_n, sn0, sn1) - m_ref;
        if (MODE == 0) mxn = sel_n ? mxn : NINF;
        if (i + 1 < nt && __builtin_amdgcn_ballot_w64(mxn > 8.0f) != 0ull) { const float dl = mxn > 0.f ? mxn : 0.f, f = __builtin_amdgcn_exp2f(-dl); m_ref += dl; l_run *= f;
#pragma unroll
            for (int r = 0; r < 16; ++r) { o0[r] *= f; o1[r] *= f; } }
        if (__builtin_amdgcn_ballot_w64(m_ref != 0.f) != 0ull) {
#pragma unroll
            for (int r = 0; r < 16; ++r) { sn0[r] -= m_ref; sn1[r] -= m_ref; } }
        sc0 = sn0; sc1 = sn1; sel_c = sel_n; mwc0 = mwn0; mwc1 = mwn1;
    }
#undef ATT_BIAS
#undef ATT_FETCH
#undef ATT_STAGE
#undef ATT_QK
    { auto rr = __builtin_amdgcn_permlane32_swap(__float_as_uint(l_run), __float_as_uint(l_run), false, false); l_run = __uint_as_float(rr[0]) + __uint_as_float(rr[1]); }
    const float rl = 1.0f / l_run;
    bf16* op = Y + (rowbase + tq) * 1024 + 512 + h * 64 + 4 * hi;
#pragma unroll
    for (int rg = 0; rg < 4; ++rg) {
        u32x2 w0, w1; w0.x = pk2(o0[4 * rg] * rl, o0[4 * rg + 1] * rl); w0.y = pk2(o0[4 * rg + 2] * rl, o0[4 * rg + 3] * rl);
        w1.x = pk2(o1[4 * rg] * rl, o1[4 * rg + 1] * rl); w1.y = pk2(o1[4 * rg + 2] * rl, o1[4 * rg + 3] * rl);
        if (!dry) { *(u32x2*)(op + 8 * rg) = w0; *(u32x2*)(op + 32 + 8 * rg) = w1; } }
    __syncthreads();
}

constexpr int CF_IN_ROWS = 62, CF_IN_BYTES = CF_IN_ROWS * 1024, CF_OUT_OFF = 63488;
__device__ __forceinline__ void conformer_unit(Frame& F, int b, int tile) {
    const float* dw_w = F.inp(23); const float* dw_b = F.inp(24); const float* ln_g = F.inp(25); const float* ln_b = F.inp(26);
    const bf16* CP = (const bf16*)(F.ws + WS_XR); bf16* Y = (bf16*)(F.ws + WS_Y);
    unsigned* cin = (unsigned*)F.lds; float* cout = (float*)(F.lds + CF_OUT_OFF);
    const int t0 = tile * 32; const size_t rowbase = (size_t)b * SEQ;
    for (int i = F.tid; i < CF_IN_ROWS * 64; i += NTHR) { const int r = i >> 6, ch = i & 63; const int t = t0 - 30 + r;
        u32x4 v = {0u, 0u, 0u, 0u}; if (t >= 0) v = *(const u32x4*)(CP + (rowbase + t) * 512 + ch * 8);
        *(u32x4*)(cin + r * 256 + ch * 4) = v; }
    const int cp = F.tid & 255, th = F.tid >> 8;
    float w0[31], w1[31];
#pragma unroll
    for (int k = 0; k < 31; ++k) { const f32x2 w = *(const f32x2*)(dw_w + k * 512 + 2 * cp); w0[k] = w.x; w1[k] = w.y; }
    const f32x2 bb = *(const f32x2*)(dw_b + 2 * cp);
    __syncthreads();
#pragma unroll 1
    for (int blk = 0; blk < 4; ++blk) { const int tau0 = th * 16 + blk * 4;
        float a0[4], a1[4];
#pragma unroll
        for (int o = 0; o < 4; ++o) { a0[o] = bb.x; a1[o] = bb.y; }
#pragma unroll
        for (int i = 0; i < 34; ++i) { const unsigned v = cin[(tau0 + i) * 256 + cp]; const float lo = bflo(v), hi = bfhi(v);
#pragma unroll
            for (int o = 0; o < 4; ++o) { const int k = i - o; if (k >= 0 && k < 31) { a0[o] += w0[k] * lo; a1[o] += w1[k] * hi; } } }
#pragma unroll
        for (int o = 0; o < 4; ++o) *(f32x2*)(cout + (tau0 + o) * 512 + 2 * cp) = (f32x2){a0[o], a1[o]};
    }
    __syncthreads();
    f32x4 g0 = *(const f32x4*)(ln_g + 8 * F.lane), g1 = *(const f32x4*)(ln_g + 8 * F.lane + 4), be0 = *(const f32x4*)(ln_b + 8 * F.lane), be1 = *(const f32x4*)(ln_b + 8 * F.lane + 4);
#pragma unroll
    for (int i = 0; i < 4; ++i) { const int tok = F.wave * 4 + i;
        f32x4 v0 = *(const f32x4*)(cout + tok * 512 + 8 * F.lane), v1 = *(const f32x4*)(cout + tok * 512 + 8 * F.lane + 4);
        const float mean = wave_sum((v0.x + v0.y) + (v0.z + v0.w) + (v1.x + v1.y) + (v1.z + v1.w)) * (1.f / 512.f);
        v0 = v0 - mean; v1 = v1 - mean;
        const float var = wave_sum((v0.x * v0.x + v0.y * v0.y) + (v0.z * v0.z + v0.w * v0.w) + (v1.x * v1.x + v1.y * v1.y) + (v1.z * v1.z + v1.w * v1.w)) * (1.f / 512.f);
        const float rstd = __builtin_amdgcn_rsqf(var + pg8::NORM_EPS);
        v0 = v0 * rstd * g0 + be0; v1 = v1 * rstd * g1 + be1;
#pragma unroll
        for (int e = 0; e < 4; ++e) { v0[e] = v0[e] * pg8::sigmoid_f(v0[e]); v1[e] = v1[e] * pg8::sigmoid_f(v1[e]); }
        *(u32x4*)(Y + (rowbase + t0 + tok) * 1024 + 8 * F.lane) = pg8::pack8(v0, v1); }
    __syncthreads();
}

constexpr int SEL_CAP = 160, QI_PITCH = 520, NBIN = 384, HROW = 385;
constexpr int SL_HIST = 0, SL_CV = 32 * HROW * 4 + 64, SL_CI = SL_CV + 32 * SEL_CAP * 4, SL_MASK = SL_CI + 32 * SEL_CAP * 4, SL_CNT = SL_MASK + 16384, SL_THR = SL_CNT + 128, SL_CAB = SL_THR + 128, SL_QI = SL_CAB + 128, SL_WQ = SL_QI + 32 * QI_PITCH * 2, SL_END = SL_WQ + 32 * 8 * 4;
static_assert(SL_END <= 147392 && SL_QI % 16 == 0, "select LDS");
__device__ __forceinline__ int sel_binoff(float v) {
    const int bits = (int)__float_as_uint(v); int mag = (int)(((unsigned)bits >> 19) & 0xfffu) - (121 << 4);
    mag = mag < 0 ? 0 : (mag > 191 ? 191 : mag);
    return mag ^ (bits >> 31);
}
__device__ __forceinline__ float relu_f(float x) { const int xi = (int)__float_as_uint(x); return __uint_as_float((unsigned)(xi < 0 ? 0 : xi)); }
template <int PASS, bool DIAG>
__device__ __forceinline__ void sel_tile(const bf16x8 (&kf)[4], const bf16* qlp, const float* wql, unsigned* histq, int thro, unsigned* cntq, float* cvq, unsigned* ciq, unsigned* maskq, int jt, int tq, int hi) {
    f32x16 isc = {};
    const __attribute__((address_space(3))) unsigned char* ql3 = (const __attribute__((address_space(3))) unsigned char*)qlp; asm volatile("" : "+v"(ql3));
#pragma unroll 4
    for (int hh = 0; hh < 8; ++hh) { f32x16 s = {};
#pragma unroll
        for (int ds = 0; ds < 4; ++ds) s = __builtin_amdgcn_mfma_f32_32x32x16_bf16(kf[ds], *(const __attribute__((address_space(3))) bf16x8*)(ql3 + 128 * hh + 32 * ds), s, 0, 0, 0);
        const float w = wql[hh];
#pragma unroll
        for (int r = 0; r < 16; ++r) { const float rl = relu_f(s[r]); asm("v_fmac_f32 %0, %1, %2" : "+v"(isc[r]) : "v"(rl), "v"(w)); } }
#ifndef SEL_PROF
#define SEL_PROF 0
#endif
    if (PASS == 2) {
        float dsum = 0.f; int bsum = 0;
#pragma unroll
        for (int r = 0; r < 16; ++r) { if (SEL_PROF <= 1) bsum += sel_binoff(isc[r]); else dsum += isc[r]; }
        if (dsum == 123.456f || bsum == 0x7fffffff) histq[0] = 1u;
        return; }
    if (PASS == 3) {
        unsigned part = 0u;
#pragma unroll
        for (int r = 0; r < 16; ++r) { const int kr = crow(r, hi), kv = jt * 32 + kr; const bool valid = !DIAG || kv <= tq; const int bo = sel_binoff(isc[r]);
            if (SEL_PROF == 4) { if (valid && bo > thro) part |= 1u << kr; }
            else { if (valid && bo == thro) { const unsigned idx = atomicAdd(cntq, 1u); if (idx < (unsigned)SEL_CAP) { cvq[idx] = isc[r]; ciq[idx] = (unsigned)kv; } } } }
        if (SEL_PROF == 4) { auto rr = __builtin_amdgcn_permlane32_swap(part, part, false, false); const unsigned word = rr[0] | rr[1]; if (hi == 0) maskq[jt] = word; }
        return; }
    unsigned part = 0u;
#pragma unroll
    for (int r = 0; r < 16; ++r) { const int kr = crow(r, hi), kv = jt * 32 + kr; const bool valid = !DIAG || kv <= tq; const int bo = sel_binoff(isc[r]);
        if (PASS == 0) { if (valid) atomicAdd(histq + bo, 1u); }
        else { if (valid && bo > thro) part |= 1u << kr;
               if (valid && bo == thro) { const unsigned idx = atomicAdd(cntq, 1u); if (idx < (unsigned)SEL_CAP) { cvq[idx] = isc[r]; ciq[idx] = (unsigned)kv; } } } }
    if (PASS == 1) { auto rr = __builtin_amdgcn_permlane32_swap(part, part, false, false); const unsigned word = rr[0] | rr[1]; if (hi == 0) maskq[jt] = word; }
}
template <int PASS>
__device__ __forceinline__ void sel_pass(Frame& F, const bf16* KI, size_t rowbase, int qg, const bf16* qlp, const float* wql, unsigned* histq, int thro, unsigned* cntq, float* cvq, unsigned* ciq, unsigned* maskq, int tq) {
    const int lane = F.lane, wid = F.wave, r32 = lane & 31, hi = lane >> 5;
    bf16x8 kn[4];
    if (wid <= qg) { const bf16* kp = KI + (rowbase + wid * 32 + r32) * 64 + 8 * hi;
#pragma unroll
        for (int ds = 0; ds < 4; ++ds) kn[ds] = *(const bf16x8*)(kp + 16 * ds); }
#pragma unroll 1
    for (int jt = wid; jt <= qg; jt += NWAVES) {
        bf16x8 kf[4];
#pragma unroll
        for (int ds = 0; ds < 4; ++ds) kf[ds] = kn[ds];
        if (jt + NWAVES <= qg) { const bf16* kp = KI + (rowbase + (jt + NWAVES) * 32 + r32) * 64 + 8 * hi;
#pragma unroll
            for (int ds = 0; ds < 4; ++ds) kn[ds] = *(const bf16x8*)(kp + 16 * ds); }
        if (jt < qg) sel_tile<PASS, false>(kf, qlp, wql, histq, thro, cntq, cvq, ciq, maskq, jt, tq, hi);
        else sel_tile<PASS, true>(kf, qlp, wql, histq, thro, cntq, cvq, ciq, maskq, jt, tq, hi);
    }
}
#ifndef SEL_DRY_LEVEL
#define SEL_DRY_LEVEL 1
#endif
__device__ __forceinline__ void dsa_select_unit(Frame& F, int b, int qg, int dry) {
    if (dry && SEL_DRY_LEVEL >= 9) return;
    const int lane = F.lane, wid = F.wave, r32 = lane & 31, hi = lane >> 5;
    const bf16* QI = (const bf16*)(F.ws + WS_QI); const bf16* KI = (const bf16*)(F.ws + WS_KI); const float* WI = (const float*)(F.ws + WS_WI);
    unsigned* MASK = (unsigned*)(F.ws + WS_MASK);
    unsigned* hist = (unsigned*)(F.lds + SL_HIST);
    float* cv = (float*)(F.lds + SL_CV); unsigned* ci = (unsigned*)(F.lds + SL_CI); unsigned* maskl = (unsigned*)(F.lds + SL_MASK);
    unsigned* cnt = (unsigned*)(F.lds + SL_CNT); int* thr = (int*)(F.lds + SL_THR); int* cab = (int*)(F.lds + SL_CAB);
    const size_t rowbase = (size_t)b * SEQ; const int tq = qg * 32 + r32;
    bf16* qil = (bf16*)(F.lds + SL_QI);
    u32x4 qv[4];
#pragma unroll
    for (int u = 0; u < 4; ++u) { const int i = F.tid + u * NTHR; qv[u] = *(const u32x4*)(QI + (rowbase + qg * 32 + (i >> 6)) * 512 + (i & 63) * 8); }
    for (int i = F.tid; i < 32 * HROW / 4; i += NTHR) ((u32x4*)hist)[i] = (u32x4){0u, 0u, 0u, 0u};
    for (int i = F.tid; i < 32 * 128 / 4; i += NTHR) ((u32x4*)maskl)[i] = (u32x4){0u, 0u, 0u, 0u};
    if (F.tid < 32) cnt[F.tid] = 0u;
#pragma unroll
    for (int u = 0; u < 4; ++u) { const int i = F.tid + u * NTHR; *(u32x4*)(qil + (i >> 6) * QI_PITCH + (i & 63) * 8) = qv[u]; }
    float* wql = (float*)(F.lds + SL_WQ) + r32 * 8;
    if (F.tid < 64) { const int r = F.tid >> 1, hf = F.tid & 1; *(f32x4*)((float*)(F.lds + SL_WQ) + r * 8 + hf * 4) = *(const f32x4*)(WI + (rowbase + qg * 32 + r) * 8 + hf * 4); }
    const bf16* qlp = qil + r32 * QI_PITCH + 8 * hi;
    unsigned* histq = hist + r32 * HROW + 192;
    __syncthreads();
    if (dry && SEL_DRY_LEVEL >= 5) { sel_pass<2>(F, KI, rowbase, qg, qlp, wql, histq, 0, cnt + r32, cv + r32 * SEL_CAP, ci + r32 * SEL_CAP, maskl + r32 * 128, tq); __syncthreads(); return; }
    if (dry && SEL_DRY_LEVEL >= 4) { __syncthreads(); return; }
    sel_pass<0>(F, KI, rowbase, qg, qlp, wql, histq, 0, cnt + r32, cv + r32 * SEL_CAP, ci + r32 * SEL_CAP, maskl + r32 * 128, tq);
    __syncthreads();
#pragma unroll 1
    for (int i = 0; i < 4; ++i) { const int q = wid * 4 + i; const int tqq = qg * 32 + q;
        const unsigned* hq = hist + q * HROW + lane * 6;
        int c[6]; c[0] = hq[0]; c[1] = hq[1]; c[2] = hq[2]; c[3] = hq[3]; c[4] = hq[4]; c[5] = hq[5];
        int tot = 0;
#pragma unroll
        for (int k = 0; k < 6; ++k) tot += c[k];
        int incl = tot;
#pragma unroll
        for (int o = 1; o < 64; o <<= 1) { const int v = __shfl_down(incl, o); if (lane + o < 64) incl += v; }
        const int above = incl - tot;
        if (tqq + 1 <= 256) { if (lane == 0) { thr[q] = -1000; cab[q] = 0; } }
        else if (above < 256 && above + tot >= 256) {
            int bsel = 0, ab = above, csel = 0;
#pragma unroll
            for (int k = 5; k >= 0; --k) { if (ab < 256 && ab + c[k] >= 256) { bsel = lane * 6 + k; csel = c[k]; break; } ab += c[k]; }
            if (csel > SEL_CAP) { thr[q] = bsel - 193; cab[q] = 256; }
            else { thr[q] = bsel - 192; cab[q] = ab; } }
    }
    __syncthreads();
    if (dry && SEL_DRY_LEVEL >= 3) { if (SEL_PROF >= 4) sel_pass<3>(F, KI, rowbase, qg, qlp, wql, histq, thr[r32], cnt + r32, cv + r32 * SEL_CAP, ci + r32 * SEL_CAP, maskl + r32 * 128, tq); __syncthreads(); return; }
    sel_pass<1>(F, KI, rowbase, qg, qlp, wql, histq, thr[r32], cnt + r32, cv + r32 * SEL_CAP, ci + r32 * SEL_CAP, maskl + r32 * 128, tq);
    __syncthreads();
    if (dry && SEL_DRY_LEVEL >= 2) { __syncthreads(); return; }
#pragma unroll 1
    for (int i = 0; i < 4; ++i) { const int q = wid * 4 + i; const int tb = thr[q];
        if (tb > -1000) { const int nc = min((int)cnt[q], SEL_CAP), need = 256 - cab[q]; const int nc4 = (nc + 3) & ~3;
            for (int k = nc + lane; k < nc4; k += 64) { cv[q * SEL_CAP + k] = -__builtin_inff(); ci[q * SEL_CAP + k] = 0xffffffffu; }
            asm volatile("s_waitcnt lgkmcnt(0)" ::: "memory");
            for (int a0 = 0; a0 < nc; a0 += 64) { const int a = a0 + lane; const bool act = a < nc;
                const float va = act ? cv[q * SEL_CAP + a] : 0.f; const unsigned ia = act ? ci[q * SEL_CAP + a] : 0u; int rank = 0;
#pragma unroll 2
                for (int k = 0; k < nc4; k += 4) { const f32x4 vk = *(const f32x4*)(cv + q * SEL_CAP + k); const u32x4 ik = *(const u32x4*)(ci + q * SEL_CAP + k);
                    rank += (vk.x > va || (vk.x == va && ik.x < ia)) ? 1 : 0; rank += (vk.y > va || (vk.y == va && ik.y < ia)) ? 1 : 0;
                    rank += (vk.z > va || (vk.z == va && ik.z < ia)) ? 1 : 0; rank += (vk.w > va || (vk.w == va && ik.w < ia)) ? 1 : 0; }
                if (act && rank < need) atomicOr(&maskl[q * 128 + (ia >> 5)], 1u << (ia & 31)); } } }
    __syncthreads();
    if (!dry) for (int i = F.tid; i < 32 * 128; i += NTHR) MASK[(rowbase + qg * 32 + (i >> 7)) * 128 + (i & 127)] = maskl[i];
    __syncthreads();
}

__device__ __forceinline__ int lane_id() { int l; asm volatile("v_mbcnt_lo_u32_b32 %0, -1, 0\n\tv_mbcnt_hi_u32_b32 %0, -1, %0" : "=v"(l)); return l; }
#define LAS __attribute__((address_space(3)))
constexpr int CW_BAR_BYTES = 16384;
constexpr int MISC_OFF = LDS_BYTES - 64;
#define XB_TMO      128
#define XB_XCNT(j)  (256  + 64 * (j))
#define XB_XSUB(j)  (1280 + 64 * (j))
#define XB_XGEN(j)  (2304 + 64 * (j))
#define XB_TOP      3328
#define XB_TOPGEN   3392
#define XCD_BAR_WORDS 3456
#define XB_SPIN_CAP (1u << 18)

__device__ __forceinline__ unsigned xb_ld(unsigned* p)              { return __hip_atomic_load(p, __ATOMIC_RELAXED, __HIP_MEMORY_SCOPE_AGENT); }
__device__ __forceinline__ unsigned xb_add(unsigned* p, unsigned v) { return __hip_atomic_fetch_add(p, v, __ATOMIC_RELAXED, __HIP_MEMORY_SCOPE_AGENT); }
__device__ __forceinline__ unsigned xb_xcc_id() { return (unsigned)__builtin_amdgcn_s_getreg((3 << 11) | 20) & 0xFu; }
#define XB_SPIN(cond, bar) do { unsigned _sp = 0; while (cond) { __builtin_amdgcn_s_sleep(1); \
    if ((++_sp & 255u) == 0u) { if (xb_ld(&(bar)[XB_TMO])) break; if (_sp > XB_SPIN_CAP) { atomicAdd(&(bar)[XB_TMO], 1u); break; } } } } while (0)

struct XcdBarrier {
    unsigned* bar; unsigned x;
    volatile LAS unsigned* st;
};

__device__ __forceinline__ XcdBarrier xcd_barrier_post(unsigned* bar, volatile LAS unsigned* st, bool leader) {
    XcdBarrier b; b.bar = bar; b.x = xb_xcc_id(); b.st = st;
    if (leader) (void)xb_add(&bar[XB_XCNT(b.x)], 1u);
    return b;
}
__device__ __forceinline__ void xcd_barrier_complete(unsigned* bar, unsigned x, unsigned& nloc, unsigned& nx) {
    const unsigned G = gridDim.x * gridDim.y * gridDim.z;
    unsigned sum, cnt, mine, sp = 0u;
    for (;;) {
        sum = 0u; cnt = 0u; mine = 0u;
#pragma unroll
        for (unsigned j = 0; j < 16; ++j) { const unsigned c = xb_ld(&bar[XB_XCNT(j)]); sum += c; cnt += (c > 0u) ? 1u : 0u; mine = (j == x) ? c : mine; }
        if (sum == G) break;
        __builtin_amdgcn_s_sleep(1);
        if ((++sp & 255u) == 0u) { if (xb_ld(&bar[XB_TMO])) break; if (sp > XB_SPIN_CAP) { atomicAdd(&bar[XB_TMO], 1u); break; } }
    }
    nloc = mine > 0u ? mine : 1u; nx = cnt > 0u ? cnt : 1u;
}

__device__ __forceinline__ void xcd_barrier(const XcdBarrier& b, bool leader) {
    asm volatile("s_waitcnt vmcnt(0)" ::: "memory");
    __syncthreads();
    if (leader) {
        unsigned* bar = b.bar;
        __builtin_amdgcn_s_waitcnt(0);
        unsigned nloc = b.st[0], nx = b.st[1];
        if (nloc == 0u) { xcd_barrier_complete(bar, b.x, nloc, nx); b.st[0] = nloc; b.st[1] = nx; }
        const unsigned old = xb_add(&bar[XB_XSUB(b.x)], 1u);
        const unsigned gen = old / nloc;
        if (old + 1u == (gen + 1u) * nloc) {
            __builtin_amdgcn_fence(__ATOMIC_RELEASE, "agent");
            asm volatile("s_waitcnt vmcnt(0)" ::: "memory");
            const unsigned og = xb_add(&bar[XB_TOP], 1u);
            const unsigned tg = og / nx;
            if (og + 1u == (tg + 1u) * nx) xb_add(&bar[XB_TOPGEN], 1u);
            else XB_SPIN(xb_ld(&bar[XB_TOPGEN]) == tg, bar);
            __builtin_amdgcn_fence(__ATOMIC_ACQUIRE, "agent");
            xb_add(&bar[XB_XGEN(b.x)], 1u);
            asm volatile("s_waitcnt vmcnt(0)" ::: "memory");
        } else {
            XB_SPIN(xb_ld(&bar[XB_XGEN(b.x)]) == gen, bar);
            __builtin_amdgcn_fence(__ATOMIC_ACQUIRE, "agent");
            asm volatile("s_waitcnt vmcnt(0)" ::: "memory");
        }
    }
    __syncthreads();
}


#ifndef KMASK
#define KMASK 0xFFFF
#endif
#define KEN(x) (((KMASK) >> (x)) & 1)
#ifndef ATT_PROF
#define ATT_PROF 0
#endif
#ifndef DUP_KIND
#define DUP_KIND -1
#endif
#define REP(k, dryv) for (int dryv = (DUP_KIND == (k)) ? 1 : 0; dryv >= 0; --dryv)
constexpr int N_PHASES = 17;
#ifndef MK_STOP_AFTER
#define MK_STOP_AFTER N_PHASES
#endif
#ifndef MK_COOP
#define MK_COOP 0
#endif

__global__ void __launch_bounds__(NTHR, 2) mega_fwd(Args args) {
    extern __shared__ __attribute__((aligned(16))) unsigned char lds[];
    Frame F;
    const int wv0 = __builtin_amdgcn_readfirstlane((int)threadIdx.x >> 6);
#define MYTID() (wv0 * 64 + lane_id())
    F.lds = lds; F.tid = MYTID(); F.lane = F.tid & 63; F.wave = wv0;
    F.G = gridDim.x; F.bid = blockIdx.x; F.ws = (unsigned char*)(GASP unsigned char*)args.ws; F.in = args.in; F.out = (float*)(GASP float*)args.out;
    cg::grid_group grid = cg::this_grid();
    PG8_LAS unsigned char* glds = (PG8_LAS unsigned char*)lds;
#if MK_COOP
    constexpr int lo = 0, hi = MK_STOP_AFTER;
#else
    const int lo = args.ph_lo, hi = args.ph_hi;
#endif
#define IN(k) (lo <= (k) && (k) < hi)
    volatile LAS unsigned* stw = (volatile LAS unsigned*)((LAS unsigned char*)lds + MISC_OFF);
    if (MYTID() < 2) stw[MYTID()] = 0u;
    __syncthreads();
    XcdBarrier bar; bar.bar = (unsigned*)(args.ws + CW_BAR_BYTES); bar.x = 0; bar.st = stw;
    if (MK_COOP) bar = xcd_barrier_post((unsigned*)((GASP unsigned char*)args.ws + CW_BAR_BYTES), stw, MYTID() == 0);
    if (args.coop == 2) grid.sync();
#define SEAM(k) do { if (IN(k) && IN((k) + 1)) { XcdBarrier b2_ = bar; unsigned long long bp_ = (unsigned long long)b2_.bar; asm volatile("" : "+s"(bp_), "+s"(b2_.x)); b2_.bar = (unsigned*)(GASP unsigned*)bp_; xcd_barrier(b2_, MYTID() == 0); } } while (0)

    if (KEN(0) && IN(0)) { REP(0, dry) p0_prologue(F); }
    SEAM(0);
#pragma unroll 1
    for (int l = 0; l < 2; ++l) {
        const int pb = 1 + 8 * l;
#define LAUNDER() unsigned long long wsi_ = (unsigned long long)args.ws, outi_ = (unsigned long long)args.out; asm volatile("" : "+s"(wsi_), "+s"(outi_)); \
        unsigned char* ws = (unsigned char*)(GASP unsigned char*)wsi_; float* outp = (float*)(GASP float*)outi_; \
        unsigned long long* RS = (unsigned long long*)(ws + WS_RS); bf16* XB = (bf16*)(ws + WS_XB); bf16* HB = (bf16*)(ws + WS_H); bf16* Y = (bf16*)(ws + WS_Y); \
        const float* xin = (l == 0) ? F.inp(0) : outp; (void)RS; (void)XB; (void)HB; (void)Y; (void)xin; F.ws = ws; F.out = outp; \
        { int wl_ = wv0; asm volatile("" : "+s"(wl_)); int tl_ = wl_ * 64 + lane_id(); asm volatile("" : "+v"(tl_)); F.tid = tl_; F.lane = tl_ & 63; F.wave = wl_; \
          int bl_ = blockIdx.x, gl_ = gridDim.x; asm volatile("" : "+s"(bl_), "+s"(gl_)); F.bid = bl_; F.G = gl_; }
        if (KEN(1) && IN(pb + 0)) { LAUNDER(); pg8::Gemm g{XB, (const pg8::bf16_t*)(ws + WS_GU0 + (size_t)(2 * l) * SZ_GU), MT, 5632, 1024}; pg8::StaticOrder S; S.init(MT, 5632, F.G, F.bid);
            pg8::EpiGU E{HB, FF, RS + (size_t)(3 * l) * MT, 0};
            REP(1, dry) { E.dry = dry; pg8::gemm_phase<pg8::EpiGU, pg8::StaticOrder, true, true>(glds, g, S, E, F.tid); }
            if (l == 0 && F.G == 256 && F.bid >= 128) conv_items(F, CV_T0, CV_T1, (F.bid - 128) * NWAVES + F.wave, 128 * NWAVES); }
        SEAM(pb + 0);
        if (KEN(2) && IN(pb + 1)) { LAUNDER(); pg8::Gemm g{HB, (const pg8::bf16_t*)(ws + WS_DN0 + (size_t)(2 * l) * SZ_DN), MT, 1024, FF}; pg8::StaticOrder S; S.init(MT, 1024, F.G, F.bid);
            pg8::EpiRes E{XB, nullptr, RS + (size_t)(3 * l + 1) * MT, 0.5f, 0};
            REP(2, dry) { E.dry = dry; pg8::gemm_phase<pg8::EpiRes, pg8::StaticOrder, true, true>(glds, g, S, E, F.tid); } }
        SEAM(pb + 1);
        if (KEN(3) && IN(pb + 2)) { LAUNDER(); const int N = l ? 3328 : 2560; pg8::Gemm g{XB, (const pg8::bf16_t*)(ws + (l ? WS_WIN1 : WS_WIN0)), MT, N, 1024}; pg8::StaticOrder S; S.init(MT, N, F.G, F.bid);
            pg8::EpiMix E{RS + (size_t)(3 * l + 1) * MT, l, Y, (bf16*)(ws + WS_XR), (bf16*)(ws + WS_K), (bf16*)(ws + WS_V), (bf16*)(ws + WS_QI), (bf16*)(ws + WS_KI),
                          F.inp(l ? 27 : 19), F.inp(l ? 28 : 20), QSCALE, (float*)(ws + WS_WI), IDX_SCALE};
            REP(3, dry) pg8::gemm_phase<pg8::EpiMix, pg8::StaticOrder, true, true>(glds, g, S, E, F.tid);
            if (l == 0 && F.G == 256 && F.bid >= 128) conv_items(F, CV_T1, CV_T2, (F.bid - 128) * NWAVES + F.wave, 128 * NWAVES); }
        SEAM(pb + 2);
        if (IN(pb + 3)) { LAUNDER();
            if (l == 0) { if (KEN(4)) REP(4, dry) for (int u = F.bid; u < 256; u += F.G) lru_unit(F, u >> 6, u & 63, 0, dry);
                          if (KEN(5)) REP(5, dry) for (int u = F.bid; u < 64; u += F.G) kmean_unit(F, u >> 4, u & 15); }
            else { if (KEN(6)) REP(6, dry) for (int u = F.bid; u < 256; u += F.G) { const int b = u >> 6, s = u & 63; dsa_select_unit(F, b, s, dry); dsa_select_unit(F, b, 127 - s, dry); }
                   if (KEN(7)) REP(7, dry) for (int u = F.bid; u < 512; u += F.G) conformer_unit(F, u >> 7, u & 127); }
        }
        SEAM(pb + 3);
        if (IN(pb + 4)) { LAUNDER();
            for (int u = F.bid; u < 256; u += F.G) { const int bh = u >> 3, s = u & 7;
                if (l == 0) { if (KEN(8)) REP(8, dry) { attn_unit<0>(F, bh >> 3, bh & 7, 15 - s, dry); attn_unit<0>(F, bh >> 3, bh & 7, s, dry); } }
                else { if (KEN(9)) REP(9, dry) { attn_unit<1>(F, bh >> 3, bh & 7, 15 - s, dry); attn_unit<1>(F, bh >> 3, bh & 7, s, dry); } } }
            if (KEN(10) && l == 0) REP(10, dry) for (int u = F.bid; u < 256; u += F.G) lru_unit(F, u >> 6, u & 63, 1, dry);
        }
        SEAM(pb + 4);
        if (KEN(2) && IN(pb + 5)) { LAUNDER(); pg8::Gemm g{Y, (const pg8::bf16_t*)(ws + (l ? WS_WOUT1 : WS_WOUT0)), MT, 1024, 1024}; pg8::StaticOrder S; S.init(MT, 1024, F.G, F.bid);
            pg8::EpiRes E{XB, nullptr, RS + (size_t)(3 * l + 2) * MT, 1.0f, 0};
            REP(2, dry) { E.dry = dry; pg8::gemm_phase<pg8::EpiRes, pg8::StaticOrder, true, true>(glds, g, S, E, F.tid); } }
        SEAM(pb + 5);
        if (KEN(1) && IN(pb + 6)) { LAUNDER(); pg8::Gemm g{XB, (const pg8::bf16_t*)(ws + WS_GU0 + (size_t)(2 * l + 1) * SZ_GU), MT, 5632, 1024}; pg8::StaticOrder S; S.init(MT, 5632, F.G, F.bid);
            pg8::EpiGU E{HB, FF, RS + (size_t)(3 * l + 2) * MT, 0};
            REP(1, dry) { E.dry = dry; pg8::gemm_phase<pg8::EpiGU, pg8::StaticOrder, true, true>(glds, g, S, E, F.tid); }
            if (l == 0 && F.G == 256 && F.bid >= 128) conv_items(F, CV_T2, CV_ALL, (F.bid - 128) * NWAVES + F.wave, 128 * NWAVES); }
        SEAM(pb + 6);
        if (KEN(2) && IN(pb + 7)) { LAUNDER(); pg8::Gemm g{HB, (const pg8::bf16_t*)(ws + WS_DN0 + (size_t)(2 * l + 1) * SZ_DN), MT, 1024, FF}; pg8::StaticOrder S; S.init(MT, 1024, F.G, F.bid);
            pg8::EpiRes E{XB, l == 0 ? nullptr : outp, l == 0 ? RS + (size_t)3 * MT : nullptr, 0.5f, 0};
            REP(2, dry) { E.dry = dry; pg8::gemm_phase<pg8::EpiRes, pg8::StaticOrder, true, true>(glds, g, S, E, F.tid); } }
        if (l == 0) SEAM(pb + 7);
    }
#undef IN
#undef SEAM
#undef LAUNDER
#undef MYTID
}

extern "C" void kernel_launch(void* const* d_in, const int* in_sizes, int n_in, void* d_out, int out_size, void* d_ws, size_t ws_size, hipStream_t stream) {
    static int grid = 0;
    if (grid == 0) {
        if (n_in != 30 || out_size != MT * DM || ws_size < WS_END) { fprintf(stderr, "kernel_launch: unexpected shapes (n_in %d out %d ws %zu)\n", n_in, out_size, ws_size); grid = -1; return; }
        int dev = 0, cus = 0, per_cu = 0;
        hipGetDevice(&dev); hipDeviceGetAttribute(&cus, hipDeviceAttributeMultiprocessorCount, dev);
        hipFuncSetAttribute((const void*)mega_fwd, hipFuncAttributeMaxDynamicSharedMemorySize, LDS_BYTES);
        hipOccupancyMaxActiveBlocksPerMultiprocessor(&per_cu, (const void*)mega_fwd, NTHR, LDS_BYTES);
        if (per_cu < 1) { fprintf(stderr, "kernel_launch: occupancy query says %d blocks/CU\n", per_cu); grid = -1; return; }
        grid = cus;
        if (grid != 256) fprintf(stderr, "kernel_launch: note: %d CUs\n", grid);
    }
    if (grid < 0) return;
    hipMemsetAsync((char*)d_ws + WS_CTL, 0, CTL_ZERO_BYTES, stream);
    Args a{};
    for (int i = 0; i < 30; ++i) a.in[i] = (const float*)d_in[i];
    a.out = (float*)d_out; a.ws = (unsigned char*)d_ws;
#if MK_COOP
    a.ph_lo = 0; a.ph_hi = MK_STOP_AFTER; a.coop = 1;
    void* kargs[] = {&a};
    hipError_t e = hipLaunchCooperativeKernel((const void*)mega_fwd, dim3(grid), dim3(NTHR), kargs, LDS_BYTES, stream);
    if (e != hipSuccess) fprintf(stderr, "cooperative launch failed: %s\n", hipGetErrorString(e));
#else
    for (int p = 0; p < MK_STOP_AFTER; ++p) { a.ph_lo = p; a.ph_hi = p + 1; a.coop = 0;
        hipLaunchKernelGGL(mega_fwd, dim3(grid), dim3(NTHR), LDS_BYTES, stream, a); }
#endif
}
```

```cpp
#include <hip/hip_runtime.h>
#include <hip/hip_cooperative_groups.h>
#include <cstdio>
#include <cstdint>
#define MK_STOP_AFTER 17
#define MK_COOP 1
#define DUP_KIND -1
#define SEL_DRY_LEVEL 1
#define ATT_DRY_LEVEL 1
#define SEL_PROF 0
#define ATT_PROF 0
#define ATT_QLDS 0
#define GU_PROF 0
#define LRU_DRY_LEVEL 1
#define DUP_N 1
#define PRB_A -1
#define PRB_B -1
namespace cg = cooperative_groups;

namespace pg8 {
#define PG8_LAS __attribute__((address_space(3)))
typedef unsigned short bf16_t;
typedef short bf16x8 __attribute__((ext_vector_type(8)));
typedef float f32x4 __attribute__((ext_vector_type(4)));
typedef unsigned u32x4 __attribute__((ext_vector_type(4)));
constexpr int BM = 256, BK = 64, HALF = 128, HTB = HALF * BK * 2  , STAGE_BYTES = 8 * HTB, NXCD = 8, WGM = 8;

__host__ __device__ __forceinline__ int lds_byte(int r, int c) { const int st = (r >> 4) * 2 + (c >> 5), rr = r & 15, cc = c & 31, ob = rr * 64 + cc * 2; return st * 1024 + (ob ^ (((ob >> 9) & 1) << 5)); }
__host__ __device__ __forceinline__ void stage_rc(int b, int& R, int& C) { const int st = b / 1024, sb = b % 1024, swz = sb ^ (((sb >> 9) & 1) << 5); R = (st >> 1) * 16 + swz / 64; C = (st & 1) * 32 + (swz % 64) / 2; }
__host__ __device__ __forceinline__ int perm32(int rho) { const int n = rho >> 4, i = rho & 15; return 8 * (i >> 2) + 4 * n + (i & 3); }

struct Unit { int pm, pn; };
struct Gemm { const bf16_t* A; const bf16_t* Bt; int M, N, K; };

struct StaticOrder {
    int nM, nN, nwg, G, c;
    __host__ __device__ void init(int M, int N, int G_, int c_) { nM = M / BM; nN = N / BM; nwg = nM * nN; G = G_; c = c_; }
    __host__ __device__ bool next(int i, Unit& u) const {
        const long L = (long)i * G + c; if (L >= nwg) return false;
        int wgid = (int)L; { const int q = nwg / NXCD, r = nwg % NXCD, xcd = wgid % NXCD, off = wgid / NXCD; wgid = (xcd < r ? xcd * (q + 1) : r * (q + 1) + (xcd - r) * q) + off; }
        const int nig = WGM * nN, gid = wgid / nig, fm = gid * WGM, gsz = (nM - fm) < WGM ? (nM - fm) : WGM;
        u.pm = fm + ((wgid % nig) % gsz); u.pn = (wgid % nig) / gsz; return true;
    }
    __device__ __forceinline__ void a_ready(const Unit&) const {}
    __device__ __forceinline__ void done(const Unit&) const {}
};


__device__ __forceinline__ unsigned cvt_pk_bf16(float lo, float hi) { unsigned r; asm volatile("v_cvt_pk_bf16_f32 %0, %1, %2" : "=v"(r) : "v"(lo), "v"(hi)); return r; }
constexpr float RS_FIX = 16777216.0f, RS_INV = 1.0f / (16777216.0f * 1024.0f), NORM_EPS = 1e-6f;
__device__ __forceinline__ float rstd_of(const unsigned long long* rs, int row) { return __builtin_amdgcn_rsqf((float)rs[row] * RS_INV + NORM_EPS); }
__device__ __forceinline__ float rstd_from(unsigned long long v) { return __builtin_amdgcn_rsqf((float)v * RS_INV + NORM_EPS); }
__device__ __forceinline__ void pre_rows(const unsigned long long* rs, const Unit& u, int wr, int fr, unsigned long long (&pre)[8]) {
    const int row0 = u.pm * BM + wr * 64 + fr;
#pragma unroll
    for (int i = 0; i < 8; ++i) pre[i] = rs[row0 + (i >> 2) * HALF + (i & 3) * 16];
}
__device__ __forceinline__ float sigmoid_f(float x) { return __builtin_amdgcn_rcpf(1.0f + __expf(-x)); }
__device__ __forceinline__ float gelu_tanh_f(float x) { const float z = 0.7978845608028654f * (x + 0.044715f * x * x * x); return x * __builtin_amdgcn_rcpf(1.0f + __expf(-2.0f * z)); }
__device__ __forceinline__ u32x4 pack8(const f32x4 a, const f32x4 b) { u32x4 w; w.x = cvt_pk_bf16(a[0], a[1]); w.y = cvt_pk_bf16(a[2], a[3]); w.z = cvt_pk_bf16(b[0], b[1]); w.w = cvt_pk_bf16(b[2], b[3]); return w; }

struct EpiGU {
    static constexpr bool PERM = true, AFTER_DRAIN = false;
    bf16_t* H; int ldh; const unsigned long long* rs; int dry;
    __device__ __forceinline__ void pre(const Unit& u, int wr, int fr, unsigned long long (&p)[8]) const { pre_rows(rs, u, wr, fr, p); }
    __device__ __forceinline__ void operator()(const f32x4 (&acc)[2][2][4][2], const Unit& u, int wr, int wc, int fr, int fq, const unsigned long long (&pre)[8]) const {
#ifndef GU_PROF
#define GU_PROF 0
#endif
        if (dry && GU_PROF == 1) return;
        const int row0 = u.pm * BM + wr * 64 + fr, col0 = u.pn * HALF + wc * 32 + 8 * fq;
#pragma unroll
        for (int ai = 0; ai < 2; ++ai)
#pragma unroll
            for (int m = 0; m < 4; ++m) { const int row = row0 + ai * HALF + m * 16; const float rstd = rstd_from(pre[ai * 4 + m]);
                f32x4 o[2];
#pragma unroll
                for (int n = 0; n < 2; ++n) { const f32x4 g = acc[ai][0][m][n] * rstd, up = acc[ai][1][m][n] * rstd;
#pragma unroll
                    for (int e = 0; e < 4; ++e) o[n][e] = g[e] * sigmoid_f(g[e]) * up[e]; }
                const u32x4 hv = pack8(o[0], o[1]); if (!dry) *(u32x4*)(H + (size_t)row * ldh + col0) = hv; }
    }
};

struct EpiRes {
    static constexpr bool PERM = true, AFTER_DRAIN = true;
    bf16_t* xb; float* out; unsigned long long* rs; float alpha; int dry;
    __device__ __forceinline__ void pre(const Unit&, int, int, unsigned long long (&)[8]) const {}
    __device__ __forceinline__ void fused(const f32x4 (&acc)[2][2][4][2], const Unit& u, int wr, int wc, int fr, int fq, PG8_LAS unsigned char*, int, int) const {
        const int row0 = u.pm * BM + wr * 64 + fr, col0 = u.pn * BM + wc * 32 + 8 * fq;
#pragma unroll
        for (int ai = 0; ai < 2; ++ai) {
            u32x4 bw[4][2];
#pragma unroll
            for (int m = 0; m < 4; ++m)
#pragma unroll
                for (int bj = 0; bj < 2; ++bj) bw[m][bj] = *(const u32x4*)(xb + (size_t)(row0 + ai * HALF + m * 16) * 1024 + col0 + bj * HALF);
#pragma unroll
            for (int m = 0; m < 4; ++m) { const int row = row0 + ai * HALF + m * 16; float ss = 0.f;
#pragma unroll
                for (int bj = 0; bj < 2; ++bj) { const size_t off = (size_t)row * 1024 + col0 + bj * HALF; const u32x4 w = bw[m][bj];
                    const f32x4 b0 = {__uint_as_float(w.x << 16), __uint_as_float(w.x & 0xffff0000u), __uint_as_float(w.y << 16), __uint_as_float(w.y & 0xffff0000u)};
                    const f32x4 b1 = {__uint_as_float(w.z << 16), __uint_as_float(w.z & 0xffff0000u), __uint_as_float(w.w << 16), __uint_as_float(w.w & 0xffff0000u)};
                    const f32x4 v0 = b0 + acc[ai][bj][m][0] * alpha, v1 = b1 + acc[ai][bj][m][1] * alpha;
                    if (!dry) { if (out) { __builtin_nontemporal_store(v0, (f32x4*)(out + off)); __builtin_nontemporal_store(v1, (f32x4*)(out + off + 4)); }     else *(u32x4*)(xb + off) = pack8(v0, v1); }
                    ss += (v0[0] * v0[0] + v0[1] * v0[1]) + (v0[2] * v0[2] + v0[3] * v0[3]) + (v1[0] * v1[0] + v1[1] * v1[1]) + (v1[2] * v1[2] + v1[3] * v1[3]); }
                if (rs && !dry) { ss += __shfl_xor(ss, 16); ss += __shfl_xor(ss, 32);
                    if (fq == 0) atomicAdd(rs + row, (unsigned long long)(ss * RS_FIX)); } }
            asm volatile("" ::: "memory"); }
    }
};

struct TileDesc { int kind; int idx; bf16_t* P; int ld; const float* gain; float scale; };
struct EpiMix {
    static constexpr bool PERM = true, AFTER_DRAIN = false;
    const unsigned long long* rs; int odd; bf16_t *Y, *XR, *K, *V, *QI, *KI; const float *qg, *kg; float qscale; float* WI; float wscale;
    __device__ __forceinline__ TileDesc desc(int pn) const {
        TileDesc t; t.gain = nullptr; t.scale = 1.f;
        if (!odd) {
            if (pn < 2) { t.kind = 0; t.idx = pn; t.P = Y; t.ld = 1024; }
            else if (pn < 4) { t.kind = 1; t.idx = pn - 2; t.P = XR; t.ld = 512; }
            else if (pn < 6) { t.kind = 2; t.idx = pn - 4; t.P = Y + 512; t.ld = 1024; t.gain = qg; t.scale = qscale; }
            else if (pn < 8) { t.kind = 2; t.idx = pn - 6; t.P = K; t.ld = 512; t.gain = kg; }
            else { t.kind = 1; t.idx = pn - 8; t.P = V; t.ld = 512; }
        } else {
            if (pn < 4) { t.kind = 3; t.idx = pn; t.P = XR; t.ld = 512; }
            else if (pn < 6) { t.kind = 2; t.idx = pn - 4; t.P = Y + 512; t.ld = 1024; t.gain = qg; t.scale = qscale; }
            else if (pn < 8) { t.kind = 2; t.idx = pn - 6; t.P = K; t.ld = 512; t.gain = kg; }
            else if (pn < 10) { t.kind = 1; t.idx = pn - 8; t.P = V; t.ld = 512; }
            else if (pn < 12) { t.kind = 1; t.idx = pn - 10; t.P = QI; t.ld = 512; }
            else { t.kind = 4; t.idx = 0; t.P = KI; t.ld = 64; }
        }
        return t;
    }
    __device__ __forceinline__ void pre(const Unit& u, int wr, int fr, unsigned long long (&p)[8]) const { pre_rows(rs, u, wr, fr, p); }
    __device__ __forceinline__ void operator()(const f32x4 (&acc)[2][2][4][2], const Unit& u, int wr, int wc, int fr, int fq, const unsigned long long (&pre)[8]) const {
        const TileDesc t = desc(u.pn);
        const int row0 = u.pm * BM + wr * 64 + fr;
        if (t.kind == 0 || t.kind == 1) {
#pragma unroll
            for (int ai = 0; ai < 2; ++ai)
#pragma unroll
                for (int m = 0; m < 4; ++m) { const int row = row0 + ai * HALF + m * 16; const float rstd = rstd_from(pre[ai * 4 + m]);
#pragma unroll
                    for (int bj = 0; bj < 2; ++bj) { f32x4 v0 = acc[ai][bj][m][0] * rstd, v1 = acc[ai][bj][m][1] * rstd;
                        if (t.kind == 0) {
#pragma unroll
                            for (int e = 0; e < 4; ++e) { v0[e] = gelu_tanh_f(v0[e]); v1[e] = gelu_tanh_f(v1[e]); } }
                        *(u32x4*)(t.P + (size_t)row * t.ld + t.idx * 256 + bj * HALF + wc * 32 + 8 * fq) = pack8(v0, v1); } }
        } else if (t.kind == 2) {
            float gn[2][2][4];
#pragma unroll
            for (int bj = 0; bj < 2; ++bj)
#pragma unroll
                for (int n = 0; n < 2; ++n)
#pragma unroll
                    for (int e = 0; e < 4; ++e) gn[bj][n][e] = t.gain[32 * bj + 8 * fq + 4 * n + e] * t.scale;
#pragma unroll
            for (int ai = 0; ai < 2; ++ai)
#pragma unroll
                for (int m = 0; m < 4; ++m) { const int row = row0 + ai * HALF + m * 16; const float rstd = rstd_from(pre[ai * 4 + m]);
                    f32x4 v[2][2]; float ss = 0.f;
#pragma unroll
                    for (int bj = 0; bj < 2; ++bj)
#pragma unroll
                        for (int n = 0; n < 2; ++n) { v[bj][n] = acc[ai][bj][m][n] * rstd; ss += (v[bj][n][0] * v[bj][n][0] + v[bj][n][1] * v[bj][n][1]) + (v[bj][n][2] * v[bj][n][2] + v[bj][n][3] * v[bj][n][3]); }
                    ss += __shfl_xor(ss, 16); ss += __shfl_xor(ss, 32);
                    const float hr = __builtin_amdgcn_rsqf(ss * (1.0f / 64.0f) + NORM_EPS);
#pragma unroll
                    for (int bj = 0; bj < 2; ++bj) {
#pragma unroll
                        for (int n = 0; n < 2; ++n)
#pragma unroll
                            for (int e = 0; e < 4; ++e) v[bj][n][e] = v[bj][n][e] * hr * gn[bj][n][e];
                        *(u32x4*)(t.P + (size_t)row * t.ld + t.idx * 256 + wc * 64 + 32 * bj + 8 * fq) = pack8(v[bj][0], v[bj][1]); } }
        } else if (t.kind == 3) {
#pragma unroll
            for (int ai = 0; ai < 2; ++ai)
#pragma unroll
                for (int m = 0; m < 4; ++m) { const int row = row0 + ai * HALF + m * 16; const float rstd = rstd_from(pre[ai * 4 + m]);
                    f32x4 o[2];
#pragma unroll
                    for (int n = 0; n < 2; ++n) { const f32x4 a = acc[ai][0][m][n] * rstd, g = acc[ai][1][m][n] * rstd;
#pragma unroll
                        for (int e = 0; e < 4; ++e) o[n][e] = a[e] * sigmoid_f(g[e]); }
                    *(u32x4*)(t.P + (size_t)row * t.ld + t.idx * HALF + wc * 32 + 8 * fq) = pack8(o[0], o[1]); }
        } else {
#pragma unroll
            for (int ai = 0; ai < 2; ++ai)
#pragma unroll
                for (int m = 0; m < 4; ++m) { const int row = row0 + ai * HALF + m * 16; const float rstd = rstd_from(pre[ai * 4 + m]);
                    const f32x4 v0 = acc[ai][0][m][0] * rstd, v1 = acc[ai][0][m][1] * rstd;
                    if (wc < 2) *(u32x4*)(t.P + (size_t)row * 64 + wc * 32 + 8 * fq) = pack8(v0, v1);
                    else if (wc == 2 && fq == 0) { *(f32x4*)(WI + (size_t)row * 8) = v0 * wscale; *(f32x4*)(WI + (size_t)row * 8 + 4) = v1 * wscale; } }
        }
    }
};

template <class Epi, class Sched, bool ALIGN_EPI = false, bool SP2 = false>
__device__ __forceinline__ void gemm_phase(PG8_LAS unsigned char* lds, const Gemm g, const Sched& S, const Epi& E, int tid_in) {
    int tid_ = tid_in; asm volatile("" : "+v"(tid_));
    const int tid = tid_, wid = __builtin_amdgcn_readfirstlane(tid >> 6), lane = tid & 63, wr = wid >> 2, wc = wid & 3, fr = lane & 15, fq = lane >> 4;
    const int K = g.K, nt = K / BK;
    unsigned voffA[2], voffB[2];
#pragma unroll
    for (int i = 0; i < 2; ++i) { int R, C; stage_rc(tid * 16 + i * 8192, R, C); const int Rb = Epi::PERM ? ((R & ~31) + perm32(R & 31)) : R;
        voffA[i] = (unsigned)(R * K + C) * 2u; voffB[i] = (unsigned)(Rb * K + C) * 2u; }
    const size_t kstep = (size_t)(BK * 2);
    const size_t hstep = (size_t)HALF * K * 2;
    const size_t tstep = 2 * hstep;
    const unsigned ldsw = (unsigned)wid * 1024u;
    const int aoff = lds_byte(wr * 64 + fr, fq * 8), boff = lds_byte(wc * 32 + fr, fq * 8);
#define PG8_SA(b, h) (((b) * 2 + (h)) * HTB)
#define PG8_SB(b, h) ((4 + (b) * 2 + (h)) * HTB)
#define PG8_STAGE(bufoff, gbase, voff) do { _Pragma("unroll") for (int _i = 0; _i < 2; ++_i) \
        __builtin_amdgcn_global_load_lds((const unsigned*)((const char*)(gbase) + (voff)[_i]), (PG8_LAS unsigned*)(lds + (bufoff) + ldsw + _i * 8192), 16, 0, 0); } while (0)
#define PG8_LDA(dst, b, h) do { _Pragma("unroll") for (int m = 0; m < 4; ++m) _Pragma("unroll") for (int k = 0; k < 2; ++k) dst[m][k] = *(const PG8_LAS bf16x8*)(lds + PG8_SA(b, h) + aoff + m * 2048 + k * 1024); } while (0)
#define PG8_LDB(dst, b, h) do { _Pragma("unroll") for (int n = 0; n < 2; ++n) _Pragma("unroll") for (int k = 0; k < 2; ++k) dst[n][k] = *(const PG8_LAS bf16x8*)(lds + PG8_SB(b, h) + boff + n * 2048 + k * 1024); } while (0)
#define PG8_MMA(ai, bj, At, Bt) do { __builtin_amdgcn_s_setprio(1); _Pragma("unroll") for (int m = 0; m < 4; ++m) _Pragma("unroll") for (int n = 0; n < 2; ++n) _Pragma("unroll") for (int k = 0; k < 2; ++k) \
        acc[ai][bj][m][n] = __builtin_amdgcn_mfma_f32_16x16x32_bf16(Bt[n][k], At[m][k], acc[ai][bj][m][n], 0, 0, 0); __builtin_amdgcn_s_setprio(0); } while (0)
#define PG8_WAIT_V(n) asm volatile("s_waitcnt vmcnt(" #n ")" ::: "memory")
#define PG8_WAIT_L(n) asm volatile("s_waitcnt lgkmcnt(" #n ")" ::: "memory")
#define PG8_BAR __builtin_amdgcn_s_barrier()
#define PG8_SCHED __builtin_amdgcn_sched_barrier(0)
    Unit cur, nxt; int ui = 0;
    if (!S.next(0, cur)) return;
    unsigned long long pre[8];
    E.pre(cur, wr, fr, pre);
    f32x4 acc[2][2][4][2];
#pragma unroll
    for (int a = 0; a < 2; ++a)
#pragma unroll
        for (int b = 0; b < 2; ++b)
#pragma unroll
            for (int m = 0; m < 4; ++m)
#pragma unroll
                for (int n = 0; n < 2; ++n) acc[a][b][m][n] = (f32x4){0.f, 0.f, 0.f, 0.f};
    bf16x8 At[4][2], B0[2][2], B1[2][2];
    const char* cA = (const char*)g.A + (size_t)cur.pm * tstep; const char* cB = (const char*)g.Bt + (size_t)cur.pn * tstep;
    S.a_ready(cur);
    if constexpr (SP2) {
        PG8_STAGE(PG8_SB(0, 0), cB, voffB); PG8_STAGE(PG8_SB(0, 1), cB + hstep, voffB); PG8_STAGE(PG8_SA(0, 0), cA, voffA); PG8_STAGE(PG8_SA(0, 1), cA + hstep, voffA);
        if (wr == 1) PG8_BAR;
        PG8_WAIT_V(2); PG8_BAR;
        PG8_STAGE(PG8_SB(1, 0), cB + kstep, voffB); PG8_STAGE(PG8_SA(1, 0), cA + kstep, voffA); PG8_STAGE(PG8_SB(1, 1), cB + hstep + kstep, voffB);
        PG8_WAIT_V(6); PG8_BAR;
    } else {
        PG8_STAGE(PG8_SB(0, 0), cB, voffB); PG8_STAGE(PG8_SA(0, 0), cA, voffA); PG8_STAGE(PG8_SB(0, 1), cB + hstep, voffB); PG8_STAGE(PG8_SA(0, 1), cA + hstep, voffA);
        if (wr == 1) PG8_BAR;
        PG8_WAIT_V(4); PG8_BAR;
        PG8_STAGE(PG8_SB(1, 0), cB + kstep, voffB); PG8_STAGE(PG8_SA(1, 0), cA + kstep, voffA); PG8_STAGE(PG8_SB(1, 1), cB + hstep + kstep, voffB);
        PG8_WAIT_V(6); PG8_BAR;
    }
    for (;;) {
        const bool has_next = S.next(ui + 1, nxt);
        const char* nA = has_next ? (const char*)g.A + (size_t)nxt.pm * tstep : cA; const char* nB = has_next ? (const char*)g.Bt + (size_t)nxt.pn * tstep : cB;
        for (int t = 0; t < nt; t += 2) {
            const bool last = (t == nt - 2);
            const char* a1 = cA + (size_t)(t + 1) * kstep;
            const char* a2 = last ? nA : cA + (size_t)(t + 2) * kstep; const char* b2 = last ? nB : cB + (size_t)(t + 2) * kstep;
            const char* a3 = a2 + kstep; const char* b3 = b2 + kstep;
            if (last && has_next) S.a_ready(nxt);
            if constexpr (SP2) {
            PG8_LDB(B0, 0, 0); PG8_LDB(B1, 0, 1); PG8_SCHED; PG8_LDA(At, 0, 0); PG8_STAGE(PG8_SA(1, 1), a1 + hstep, voffA);
            PG8_WAIT_V(8); PG8_WAIT_L(0); PG8_BAR; PG8_MMA(0, 0, At, B0); PG8_MMA(0, 1, At, B1); PG8_BAR; PG8_SCHED;
            PG8_LDA(At, 0, 1); PG8_STAGE(PG8_SB(0, 0), b2, voffB); PG8_STAGE(PG8_SB(0, 1), b2 + hstep, voffB); PG8_STAGE(PG8_SA(0, 0), a2, voffA);
            PG8_WAIT_V(8); PG8_WAIT_L(0); PG8_BAR; PG8_MMA(1, 0, At, B0); PG8_MMA(1, 1, At, B1); PG8_BAR; PG8_SCHED;
            PG8_LDB(B0, 1, 0); PG8_LDB(B1, 1, 1); PG8_SCHED; PG8_LDA(At, 1, 0); PG8_STAGE(PG8_SA(0, 1), a2 + hstep, voffA);
            PG8_WAIT_V(8); PG8_WAIT_L(0); PG8_BAR; PG8_MMA(0, 0, At, B0); PG8_MMA(0, 1, At, B1); PG8_BAR; PG8_SCHED;
            PG8_LDA(At, 1, 1); PG8_STAGE(PG8_SB(1, 0), b3, voffB); PG8_STAGE(PG8_SB(1, 1), b3 + hstep, voffB); PG8_STAGE(PG8_SA(1, 0), a3, voffA);
            PG8_WAIT_V(8); PG8_WAIT_L(0); PG8_BAR; PG8_MMA(1, 0, At, B0); PG8_MMA(1, 1, At, B1); PG8_BAR; PG8_SCHED;
            } else {
            PG8_LDB(B0, 0, 0); PG8_SCHED; PG8_LDA(At, 0, 0); PG8_STAGE(PG8_SA(1, 1), a1 + hstep, voffA);
            PG8_WAIT_L(8); PG8_BAR; PG8_WAIT_L(0); PG8_MMA(0, 0, At, B0); PG8_BAR; PG8_SCHED;
            PG8_LDB(B1, 0, 1); PG8_STAGE(PG8_SB(0, 0), b2, voffB);
            PG8_BAR; PG8_WAIT_L(0); PG8_MMA(0, 1, At, B1); PG8_BAR;
            PG8_LDA(At, 0, 1); PG8_STAGE(PG8_SA(0, 0), a2, voffA);
            PG8_BAR; PG8_WAIT_L(0); PG8_MMA(1, 0, At, B0); PG8_BAR; PG8_SCHED;
            PG8_STAGE(PG8_SB(0, 1), b2 + hstep, voffB);
            PG8_WAIT_V(6); PG8_BAR; PG8_MMA(1, 1, At, B1); PG8_BAR;
            PG8_LDB(B0, 1, 0); PG8_SCHED; PG8_LDA(At, 1, 0); PG8_STAGE(PG8_SA(0, 1), a2 + hstep, voffA);
            PG8_WAIT_L(8); PG8_BAR; PG8_WAIT_L(0); PG8_MMA(0, 0, At, B0); PG8_BAR; PG8_SCHED;
            PG8_LDB(B1, 1, 1); PG8_STAGE(PG8_SB(1, 0), b3, voffB);
            PG8_BAR; PG8_WAIT_L(0); PG8_MMA(0, 1, At, B1); PG8_BAR;
            PG8_LDA(At, 1, 1); PG8_STAGE(PG8_SA(1, 0), a3, voffA);
            PG8_BAR; PG8_WAIT_L(0); PG8_MMA(1, 0, At, B0); PG8_BAR; PG8_SCHED;
            PG8_STAGE(PG8_SB(1, 1), b3 + hstep, voffB);
            PG8_WAIT_V(6); PG8_BAR; PG8_MMA(1, 1, At, B1); PG8_BAR;
            }
        }
        if constexpr (ALIGN_EPI) { if (wr == 0) PG8_BAR; }
        if constexpr (!Epi::AFTER_DRAIN) { E(acc, cur, wr, wc, fr, fq, pre); S.done(cur); }
        if (!has_next) break;
#pragma unroll
        for (int a = 0; a < 2; ++a)
#pragma unroll
            for (int b = 0; b < 2; ++b)
#pragma unroll
                for (int m = 0; m < 4; ++m)
#pragma unroll
                    for (int n = 0; n < 2; ++n) acc[a][b][m][n] = (f32x4){0.f, 0.f, 0.f, 0.f};
        cur = nxt; cA = nA; cB = nB; ++ui;
        E.pre(cur, wr, fr, pre);
        if constexpr (ALIGN_EPI) { if (wr == 1) PG8_BAR; }
    }
    PG8_WAIT_V(0);
    if constexpr (!ALIGN_EPI) { if (wr == 0) PG8_BAR; }
    PG8_BAR;
    if constexpr (Epi::AFTER_DRAIN) { E.fused(acc, cur, wr, wc, fr, fq, lds, wid, lane); S.done(cur); }
#undef PG8_SA
#undef PG8_SB
#undef PG8_STAGE
#undef PG8_LDA
#undef PG8_LDB
#undef PG8_MMA
#undef PG8_WAIT_V
#undef PG8_WAIT_L
#undef PG8_BAR
#undef PG8_SCHED
}
}

constexpr int NB = 4, SEQ = 4096, DM = 1024, MT = NB * SEQ, FF = 2816;
constexpr int NH = 8, HD = 64, NBLK = SEQ / 256;
constexpr float LOG2E = 1.4426950408889634f, NEGF = -1e30f;
constexpr float QSCALE = 0.125f * LOG2E;
constexpr float IDX_SCALE = 0.125f * 0.35355339059327373f;
constexpr int NWAVES = 8, NTHR = 512;

constexpr size_t MiB = 1u << 20;
constexpr size_t WS_CTL = 0, CTL_ZERO_BYTES = 1 * MiB;
constexpr size_t WS_RS = 64 * 1024;
constexpr size_t WS_KMEAN = 1 * MiB;
constexpr size_t WS_LSUM = 1 * MiB + 256 * 1024;
constexpr size_t WS_W = 4 * MiB;
constexpr size_t SZ_GU = (size_t)5632 * 1024 * 2, SZ_DN = (size_t)1024 * 2816 * 2;
constexpr size_t WS_GU0 = WS_W, WS_DN0 = WS_GU0 + 4 * SZ_GU, WS_WIN0 = WS_DN0 + 4 * SZ_DN, WS_WIN1 = WS_WIN0 + (size_t)2560 * 1024 * 2,
                 WS_WOUT0 = WS_WIN1 + (size_t)3328 * 1024 * 2, WS_WOUT1 = WS_WOUT0 + 2 * MiB, WS_WEND = WS_WOUT1 + 2 * MiB;
static_assert(WS_WEND <= 86 * MiB, "weights");
constexpr size_t WS_XB = 86 * MiB;
constexpr size_t WS_H = 118 * MiB;
constexpr size_t WS_Y = 118 * MiB, WS_K = 150 * MiB, WS_V = 166 * MiB, WS_XR = 182 * MiB, WS_QI = 198 * MiB, WS_KI = 214 * MiB, WS_WI = 216 * MiB, WS_MASK = 217 * MiB, WS_END = 225 * MiB;

constexpr int LDS_BYTES = 147456;

typedef unsigned short bf16;
typedef float f32x4 __attribute__((ext_vector_type(4)));
typedef float f32x2 __attribute__((ext_vector_type(2)));
typedef float f32x16 __attribute__((ext_vector_type(16)));
typedef unsigned u32x4 __attribute__((ext_vector_type(4)));
typedef unsigned u32x2 __attribute__((ext_vector_type(2)));
typedef short bf16x8 __attribute__((ext_vector_type(8)));
typedef short bf16x4 __attribute__((ext_vector_type(4)));

__device__ __forceinline__ float bf2f(unsigned short v) { return __uint_as_float((unsigned)v << 16); }
__device__ __forceinline__ float bflo(unsigned v) { return __uint_as_float(v << 16); }
__device__ __forceinline__ float bfhi(unsigned v) { return __uint_as_float(v & 0xffff0000u); }
__device__ __forceinline__ unsigned f2bf(float f) { unsigned u = __float_as_uint(f); return (u + 0x7fffu + ((u >> 16) & 1u)) >> 16; }
__device__ __forceinline__ unsigned pk2(float lo, float hi) { return pg8::cvt_pk_bf16(lo, hi); }
__device__ __forceinline__ float wave_sum(float v) {
#pragma unroll
    for (int o = 1; o < 64; o <<= 1) v += __shfl_xor(v, o);
    return v;
}
__device__ __forceinline__ int crow(int r, int hi) { return (r & 3) + 8 * (r >> 2) + 4 * hi; }

struct Args { const float* in[30]; float* out; unsigned char* ws; int ph_lo, ph_hi, coop, pad; };

#define GASP __attribute__((address_space(1)))
struct Frame {
    unsigned char* lds; int tid, lane, wave, G, bid;
    unsigned char* ws; const float* const* in; float* out;
    __device__ __forceinline__ const float* inp(int i) const { return (const float*)(GASP const float*)in[i]; }
};

struct WSrc { const float* W; int ldw; int col0; int ncols; const float* gain; };
__device__ __forceinline__ WSrc src_group(const float* const* in_, int mat, int grp) {
    auto in = [&](int i) -> const float* { return (const float*)(GASP const float*)in_[i]; };
    WSrc s; s.ncols = 32; s.gain = nullptr;
    if (mat < 4) { const int l = mat >> 1, f = mat & 1; const int t = grp >> 3, gg = grp & 7, bj = gg >> 2, x0 = (gg & 3) * 32;
        const float* wg = in(f ? 8 : 3); const float* wu = in(f ? 9 : 4);
        s.W = (bj ? wu : wg) + (size_t)l * 1024 * 2816; s.ldw = 2816; s.col0 = 128 * t + x0; s.gain = in(f ? 7 : 2) + l * 1024; }
    else if (mat < 8) { const int l = (mat - 4) >> 1, f = (mat - 4) & 1; s.W = in(f ? 10 : 5) + (size_t)l * 2816 * 1024; s.ldw = 1024; s.col0 = grp * 32; }
    else if (mat == 8) { const int t = grp >> 3, gg = grp & 7; s.W = in(11); s.ldw = 2560; s.gain = in(6);
        const int ty = t >> 1;
        if (ty == 2 || ty == 3) { const int bj = gg >> 2, wc = gg & 3; s.col0 = 256 * t + 64 * wc + 32 * bj; } else s.col0 = 256 * t + 32 * gg; }
    else if (mat == 9) { const int t = grp >> 3, gg = grp & 7; s.W = in(22); s.ldw = 3144; s.gain = in(6) + 1024;
        if (t < 4) { const int bj = gg >> 2, x0 = (gg & 3) * 32; s.col0 = (bj ? 512 : 0) + 128 * t + x0; }
        else if (t < 8) { const int bj = gg >> 2, wc = gg & 3; s.col0 = 1024 + 256 * (t - 4) + 64 * wc + 32 * bj; }
        else if (t < 12) s.col0 = 2048 + 256 * (t - 8) + 32 * gg;
        else { s.col0 = 3072 + 32 * gg; s.ncols = gg < 2 ? 32 : (gg == 2 ? 8 : 0); } }
    else if (mat == 10) { s.W = in(21); s.ldw = 1024; s.col0 = grp * 32; }
    else { s.W = in(29); s.ldw = 1024; s.col0 = grp * 32; }
    return s;
}
__device__ __forceinline__ void p0_item(const WSrc s0, const WSrc s1, int K, bf16* WT, int grp64, int kb, float* scr, int lane) {
    const int k0 = 64 * kb; const int kq = lane >> 4, nc = lane & 15, half = nc >> 3, cin = 4 * (nc & 7);
    const int col = (half ? s1.col0 : s0.col0) + cin; const bool ok = cin < (half ? s1.ncols : s0.ncols);
    const float* wp = s0.W + (size_t)(k0 + kq) * s0.ldw + col; const float* gp = s0.gain ? s0.gain + k0 + kq : nullptr;
#pragma unroll
    for (int i = 0; i < 16; ++i) { f32x4 v = {0.f, 0.f, 0.f, 0.f};
        if (ok) { v = __builtin_nontemporal_load((const f32x4*)(wp + (size_t)(4 * i) * s0.ldw)); if (gp) v = v * gp[4 * i]; }
        float* d = scr + (4 * i + kq) * 65 + 4 * nc; d[0] = v.x; d[1] = v.y; d[2] = v.z; d[3] = v.w; }
    asm volatile("s_waitcnt lgkmcnt(0)" ::: "memory");
    const int c = lane & 7, ns = lane >> 3;
#pragma unroll
    for (int j = 0; j < 8; ++j) { const int n = 8 * j + ns; const float* sp = scr + (8 * c) * 65 + n;
        u32x4 o; o.x = pk2(sp[0 * 65], sp[1 * 65]); o.y = pk2(sp[2 * 65], sp[3 * 65]); o.z = pk2(sp[4 * 65], sp[5 * 65]); o.w = pk2(sp[6 * 65], sp[7 * 65]);
        *(u32x4*)(WT + (size_t)(grp64 * 64 + n) * K + k0 + 8 * c) = o; }
    asm volatile("s_waitcnt lgkmcnt(0)" ::: "memory");
}
__device__ __forceinline__ void lru_prep_weights(Frame& F);
constexpr int CV_L0 = 1408 + 1408 + 704 + 704 + 640 + 256, CV_L1 = 1408 + 1408 + 704 + 704 + 832 + 256, CV_ALL = CV_L0 + CV_L1;
constexpr int CV_P = 1408, CV_T1 = CV_P + 1840, CV_T3 = CV_T1 + 1440, CV_T7 = CV_T3 + 1840, CV_T9 = CV_T7 + 1792, CV_T11 = CV_T9 + 1408;
static_assert(CV_T11 + 704 == CV_ALL, "conversion slots");
__device__ __forceinline__ int cv_map(int v) {
    if (v < 1408) return v;
    if (v < 2112) return 2816 + (v - 1408);
    if (v < 2752) return 4224 + (v - 2112);
    if (v < 3008) return 4864 + (v - 2752);
    if (v < 3248) return 1408 + (v - 3008);
    if (v < 4416) return 1648 + (v - 3248);
    if (v < 4688) return 3520 + (v - 4416);
    if (v < 5120) return 3792 + (v - 4688);
    if (v < 6528) return 5120 + (v - 5120);
    if (v < 7232) return 7936 + (v - 6528);
    if (v < 8064) return 9344 + (v - 7232);
    if (v < 8320) return 10176 + (v - 8064);
    if (v < 9728) return 6528 + (v - 8320);
    return 8640 + (v - 9728);
}
__device__ __forceinline__ void conv_items(Frame& F, int first, int last, int worker, int nworkers) {
    float* scr = (float*)(F.lds + F.wave * 16640);
    for (int vi = first + worker; vi < last; vi += nworkers) { const int it = cv_map(vi);
        const int l = it >= CV_L0 ? 1 : 0; int r = it - l * CV_L0, mat, K, ngrp; bf16* WT;
        const int nwin = l ? 832 : 640;
        if (r < 2816) { const int f = r / 1408; r -= f * 1408; mat = 2 * l + f; K = 1024; ngrp = 88; WT = (bf16*)(F.ws + WS_GU0 + (size_t)mat * SZ_GU); }
        else if ((r -= 2816) < 1408) { const int f = r / 704; r -= f * 704; mat = 4 + 2 * l + f; K = 2816; ngrp = 16; WT = (bf16*)(F.ws + WS_DN0 + (size_t)(2 * l + f) * SZ_DN); }
        else if ((r -= 1408) < nwin) { mat = 8 + l; K = 1024; ngrp = l ? 52 : 40; WT = (bf16*)(F.ws + (l ? WS_WIN1 : WS_WIN0)); }
        else { r -= nwin; mat = 10 + l; K = 1024; ngrp = 16; WT = (bf16*)(F.ws + (l ? WS_WOUT1 : WS_WOUT0)); }
        const int kb = r / ngrp, grp = r % ngrp;
        p0_item(src_group(F.in, mat, 2 * grp), src_group(F.in, mat, 2 * grp + 1), K, WT, grp, kb, scr, F.lane);
    }
}
__device__ __forceinline__ void p0_prologue(Frame& F) {
    const int gw = F.bid * NWAVES + F.wave, NGW = F.G * NWAVES;
    conv_items(F, 0, F.G == 256 ? CV_P : CV_ALL, gw, NGW);
    lru_prep_weights(F);
    const float* x = F.inp(0); bf16* XB = (bf16*)(F.ws + WS_XB); unsigned long long* rs0 = (unsigned long long*)(F.ws + WS_RS);
    for (int m0 = gw; m0 < MT; m0 += 4 * NGW) {
        f32x4 v[4][4];
#pragma unroll
        for (int rr = 0; rr < 4; ++rr) { const int m = m0 + rr * NGW; const f32x4* xr = (const f32x4*)(x + (size_t)(m < MT ? m : m0) * DM) + F.lane;
#pragma unroll
            for (int j = 0; j < 4; ++j) v[rr][j] = __builtin_nontemporal_load(xr + 64 * j); }
#pragma unroll
        for (int rr = 0; rr < 4; ++rr) { const int m = m0 + rr * NGW; if (m < MT) { unsigned long long* o8 = (unsigned long long*)(XB + (size_t)m * DM) + F.lane; float s = 0.f;
#pragma unroll
            for (int j = 0; j < 4; ++j) { const f32x4 w = v[rr][j]; s += (w.x * w.x + w.y * w.y) + (w.z * w.z + w.w * w.w);
                o8[64 * j] = (unsigned long long)pk2(w.x, w.y) | ((unsigned long long)pk2(w.z, w.w) << 32); }
            s = wave_sum(s);
            if (F.lane == 0) rs0[m] = (unsigned long long)(s * pg8::RS_FIX); } }
    }
}

constexpr int XC_PITCH = 520, LRU_GY_OFF = 64 * XC_PITCH * 2;
constexpr size_t WS_WLRU = 2 * MiB + 512 * 1024;
__device__ __forceinline__ void lru_prep_weights(Frame& F) {
    const int gt = F.bid * NTHR + F.tid; if (gt >= 8192) return;
    const int lane = gt & 63, ks = (gt >> 6) & 3, ct = (gt >> 8) & 1, g = (gt >> 9) & 7, mat = gt >> 12, r32 = lane & 31, hi = lane >> 5;
    const float* W = F.inp(mat ? 16 : 14) + (size_t)g * 4096 + (16 * ks + 8 * hi) * 64 + 32 * ct + r32;
    u32x4 o; o.x = pk2(W[0], W[64]); o.y = pk2(W[128], W[192]); o.z = pk2(W[256], W[320]); o.w = pk2(W[384], W[448]);
    *(u32x4*)((bf16*)(F.ws + WS_WLRU) + (size_t)gt * 8) = o;
}
__device__ __forceinline__ void lru_unit(Frame& F, int b, int j, int pass, int dry) {
    typedef short v4i16_t __attribute__((ext_vector_type(4))); typedef __attribute__((address_space(3))) v4i16_t* lds_v4p;
    const int c = F.tid, lane = F.lane, g = F.wave, r32 = lane & 31, hi = lane >> 5;
    const float* conv_w = F.inp(12); const float* conv_b = F.inp(13); const float* ra_b = F.inp(15); const float* ix_b = F.inp(17); const float* lam = F.inp(18);
    const bf16* XR = (const bf16*)(F.ws + WS_XR); bf16* Y = (bf16*)(F.ws + WS_Y); float* LSUM = (float*)(F.ws + WS_LSUM);
    bf16* XC = (bf16*)F.lds; bf16* GY = (bf16*)(F.lds + LRU_GY_OFF);
    const int t0 = j * 64; const size_t row0 = (size_t)b * SEQ + t0;
    { const int cg8 = c & 63, tg = c >> 6, ch0 = cg8 * 8, tb = tg * 8;
      f32x4 w[4][2];
#pragma unroll
      for (int k = 0; k < 4; ++k) { w[k][0] = *(const f32x4*)(conv_w + k * 512 + ch0); w[k][1] = *(const f32x4*)(conv_w + k * 512 + ch0 + 4); }
      const f32x4 cb0 = *(const f32x4*)(conv_b + ch0), cb1 = *(const f32x4*)(conv_b + ch0 + 4);
#pragma unroll 1
      for (int hf = 0; hf < 2; ++hf) { const int tb4 = tb + 4 * hf;
          u32x4 xr[7], gv[4];
#pragma unroll
          for (int i = 0; i < 7; ++i) { const int t = tb4 - 3 + i; xr[i] = (u32x4){0u, 0u, 0u, 0u}; if (t0 + t >= 0) xr[i] = *(const u32x4*)(XR + ((long)row0 + t) * 512 + ch0); }
          if (pass) {
#pragma unroll
              for (int u = 0; u < 4; ++u) { const int i = c + (4 * hf + u) * NTHR; gv[u] = *(const u32x4*)(Y + (row0 + (i >> 6)) * 1024 + (i & 63) * 8); }
#pragma unroll
              for (int u = 0; u < 4; ++u) { const int i = c + (4 * hf + u) * NTHR; *(u32x4*)(GY + (i >> 6) * XC_PITCH + (i & 63) * 8) = gv[u]; } }
#pragma unroll
          for (int tt = 0; tt < 4; ++tt) { f32x4 a0 = cb0, a1 = cb1;
#pragma unroll
              for (int k = 0; k < 4; ++k) { const u32x4 v = xr[tt + k];
                  a0 += w[k][0] * (f32x4){bflo(v.x), bfhi(v.x), bflo(v.y), bfhi(v.y)}; a1 += w[k][1] * (f32x4){bflo(v.z), bfhi(v.z), bflo(v.w), bfhi(v.w)}; }
              *(u32x4*)(XC + (tb4 + tt) * XC_PITCH + ch0) = pg8::pack8(a0, a1); } } }
    __syncthreads();
#ifndef LRU_DRY_LEVEL
#define LRU_DRY_LEVEL 1
#endif
    if (dry && LRU_DRY_LEVEL == 2) { __syncthreads(); return; }
    bf16x8 wfa[2][4], wfx[2][4];
    { const bf16* wl = (const bf16*)(F.ws + WS_WLRU) + (size_t)lane * 8;
#pragma unroll
      for (int ct = 0; ct < 2; ++ct)
#pragma unroll
          for (int ks = 0; ks < 4; ++ks) { wfa[ct][ks] = *(const bf16x8*)(wl + (size_t)(((0 * 8 + g) * 2 + ct) * 4 + ks) * 512); wfx[ct][ks] = *(const bf16x8*)(wl + (size_t)(((1 * 8 + g) * 2 + ct) * 4 + ks) * 512); } }
    float carry[2], aprod[2], ba[2], bx[2], sp8[2];
#pragma unroll
    for (int ct = 0; ct < 2; ++ct) { const int ch = 64 * g + 32 * ct + r32; ba[ct] = ra_b[ch]; bx[ct] = ix_b[ch]; sp8[ct] = -8.0f * log1pf(expf(-lam[ch])); carry[ct] = 0.f; aprod[ct] = 1.f; }
    if (pass) { const float* sm0 = LSUM + ((size_t)b * 64 * 512 + 64 * g + r32) * 2;
        int jj = 0;
        for (; jj + 16 <= j; jj += 16) { f32x2 v0[16], v1[16];
#pragma unroll
            for (int u = 0; u < 16; ++u) { v0[u] = *(const f32x2*)(sm0 + (size_t)(jj + u) * 1024); v1[u] = *(const f32x2*)(sm0 + (size_t)(jj + u) * 1024 + 64); }
#pragma unroll
            for (int u = 0; u < 16; ++u) { carry[0] = v0[u].x * carry[0] + v0[u].y; carry[1] = v1[u].x * carry[1] + v1[u].y; } }
        if (jj < j) { f32x2 v0[16], v1[16];
#pragma unroll
            for (int u = 0; u < 16; ++u) { const int jc = jj + u < j ? jj + u : jj; v0[u] = *(const f32x2*)(sm0 + (size_t)jc * 1024); v1[u] = *(const f32x2*)(sm0 + (size_t)jc * 1024 + 64); }
#pragma unroll
            for (int u = 0; u < 16; ++u) if (jj + u < j) { carry[0] = v0[u].x * carry[0] + v0[u].y; carry[1] = v1[u].x * carry[1] + v1[u].y; } } }
    if (dry && LRU_DRY_LEVEL == 3) { if (carry[0] + carry[1] + ba[0] + sp8[1] == 123.f) XC[0] = 1; __syncthreads(); return; }
#pragma unroll 1
    for (int tt = 0; tt < 2; ++tt) {
#pragma unroll
        for (int ct = 0; ct < 2; ++ct) {
            f32x16 accA = {}, accX = {};
#pragma unroll
            for (int ks = 0; ks < 4; ++ks) { const bf16x8 af = *(const bf16x8*)(XC + (32 * tt + r32) * XC_PITCH + 64 * g + 16 * ks + 8 * hi);
                accA = __builtin_amdgcn_mfma_f32_32x32x16_bf16(af, wfa[ct][ks], accA, 0, 0, 0);
                accX = __builtin_amdgcn_mfma_f32_32x32x16_bf16(af, wfx[ct][ks], accX, 0, 0, 0); }
            const int trow = 32 * tt + 4 * hi + ((lane & 15) >> 2), tcol = 64 * g + 32 * ct + 16 * ((lane >> 4) & 1) + 4 * (lane & 3);
            float av[16], uv[16];
#pragma unroll
            for (int gq = 0; gq < 4; ++gq) {
                const bf16x4 xq = __builtin_bit_cast(bf16x4, __builtin_amdgcn_ds_read_tr16_b64_v4i16((lds_v4p)(XC + (trow + 8 * gq) * XC_PITCH + tcol)));
#pragma unroll
                for (int e = 0; e < 4; ++e) { const int r = 4 * gq + e;
                    const float rr = pg8::sigmoid_f(accA[r] + ba[ct]), ig = pg8::sigmoid_f(accX[r] + bx[ct]);
                    const float la = sp8[ct] * rr, a = __expf(la);
                    const float om = (la > -0.05f) ? -2.0f * la * (1.0f + la * (1.0f + la * 0.6666667f)) : 1.0f - a * a;
                    av[r] = a; uv[r] = sqrtf(om) * ig * bf2f((unsigned short)xq[e]); } }
            float P[4], Sg[4], Pp[4], Sp[4], hin[4];
#pragma unroll
            for (int gq = 0; gq < 4; ++gq) { float p = 1.f, s = 0.f;
#pragma unroll
                for (int e = 0; e < 4; ++e) { s = av[4 * gq + e] * s + uv[4 * gq + e]; p *= av[4 * gq + e]; }
                P[gq] = p; Sg[gq] = s;
                auto r1 = __builtin_amdgcn_permlane32_swap(__float_as_uint(p), __float_as_uint(p), false, false); Pp[gq] = __uint_as_float(hi ? r1[0] : r1[1]);
                auto r2 = __builtin_amdgcn_permlane32_swap(__float_as_uint(s), __float_as_uint(s), false, false); Sp[gq] = __uint_as_float(hi ? r2[0] : r2[1]); }
            float h = carry[ct], ap = aprod[ct];
#pragma unroll
            for (int gq = 0; gq < 4; ++gq) { const float P0 = hi ? Pp[gq] : P[gq], S0 = hi ? Sp[gq] : Sg[gq], P1 = hi ? P[gq] : Pp[gq], S1 = hi ? Sg[gq] : Sp[gq];
                const float h0 = h; h = P0 * h + S0; const float h1 = h; h = P1 * h + S1; hin[gq] = hi ? h1 : h0; ap *= P0 * P1; }
            carry[ct] = h; aprod[ct] = ap;
            if (pass) {
#pragma unroll
                for (int gq = 0; gq < 4; ++gq) { float hh = hin[gq];
                    const bf16x4 gq4 = __builtin_bit_cast(bf16x4, __builtin_amdgcn_ds_read_tr16_b64_v4i16((lds_v4p)(GY + (trow + 8 * gq) * XC_PITCH + tcol)));
#pragma unroll
                    for (int e = 0; e < 4; ++e) { const int r = 4 * gq + e; hh = av[r] * hh + uv[r];
                        GY[(32 * tt + 8 * gq + 4 * hi + e) * XC_PITCH + 64 * g + 32 * ct + r32] = (bf16)f2bf(hh * bf2f((unsigned short)gq4[e])); } } }
        }
    }
    if (!pass) { if (hi == 0 && !dry) {
#pragma unroll
        for (int ct = 0; ct < 2; ++ct) *(f32x2*)(LSUM + (((size_t)b * 64 + j) * 512 + 64 * g + 32 * ct + r32) * 2) = (f32x2){aprod[ct], carry[ct]}; } }
    else { __syncthreads();
        if (!dry) for (int i = c; i < 64 * 64; i += NTHR) { const int r = i >> 6, ch = i & 63; *(u32x4*)(Y + (row0 + r) * 1024 + ch * 8) = *(const u32x4*)(GY + r * XC_PITCH + ch * 8); } }
    __syncthreads();
}

#define KMP_STRIDE ((size_t)NB * NH * 16 * 64)
__device__ __forceinline__ void kmean_unit(Frame& F, int b, int blk, int qtr) {
    const unsigned* K32 = (const unsigned*)(F.ws + WS_K); float* KM = (float*)(F.ws + WS_MASK) + (size_t)qtr * KMP_STRIDE;
    const int cp = F.tid & 255, half = F.tid >> 8; const size_t row0 = (size_t)b * SEQ + blk * 256 + qtr * 64 + half * 32;
    unsigned v[32];
#pragma unroll
    for (int r = 0; r < 32; ++r) v[r] = K32[(row0 + r) * 256 + cp];
    float s0 = 0.f, s1 = 0.f;
#pragma unroll
    for (int r = 0; r < 32; ++r) { s0 += bflo(v[r]); s1 += bfhi(v[r]); }
    f32x2* red = (f32x2*)F.lds;
    __syncthreads();
    if (half) red[cp] = (f32x2){s0, s1};
    __syncthreads();
    if (!half) { const f32x2 o = red[cp]; const int col = 2 * cp, hh = col >> 6, d = col & 63;
        *(f32x2*)(KM + (((size_t)b * NH + hh) * 16 + blk) * 64 + d) = (f32x2){s0 + o.x, s1 + o.y}; }
    __syncthreads();
}

constexpr int KT_PITCH = 72, VT_PITCH = 96;
constexpr int AL_KV = 0, AL_KVBUF = 9216 + 12288, AL_LUT = 3 * AL_KVBUF, AL_KM = AL_LUT + 3072, AL_FLAG = AL_KM + 4096, AL_GATE = AL_FLAG + 64, AL_TL = AL_GATE + 16384, AL_QS = AL_TL + 512, AL_END = AL_QS + 256 * 72 * 2;
__device__ __forceinline__ int rel_bucket(int n) {
    if (n < 16) return n;
    int b = 16;
    b += (n >= 19) + (n >= 21) + (n >= 24) + (n >= 27) + (n >= 31) + (n >= 35) + (n >= 40) + (n >= 46) + (n >= 52) + (n >= 59) + (n >= 67) + (n >= 77) + (n >= 87) + (n >= 99) + (n >= 113);
    return b;
}
__device__ __forceinline__ float max3_f(float a, float b, float c) { float r; asm("v_max3_f32 %0, %1, %2, %3" : "=v"(r) : "v"(a), "v"(b), "v"(c)); return r; }
#ifndef ATT_PROF
#define ATT_PROF 0
#endif
#ifndef ATT_DRY_LEVEL
#define ATT_DRY_LEVEL 1
#endif
template <int MODE  >
__device__ __forceinline__ void attn_unit(Frame& F, int b, int h, int qb, int dry) {
    typedef short v4i16_t __attribute__((ext_vector_type(4))); typedef __attribute__((address_space(3))) v4i16_t* lds_v4p;
    const int tid = F.tid, lane = F.lane, wid = F.wave, r32 = lane & 31, hi = lane >> 5;
    if (dry && ATT_DRY_LEVEL == 5) return;
    const int PROF = (ATT_PROF != 0 && dry) ? ATT_PROF : 0;
    bf16* Y = (bf16*)(F.ws + WS_Y); const bf16* Kg = (const bf16*)(F.ws + WS_K); const bf16* Vg = (const bf16*)(F.ws + WS_V);
    const float* rel_bias = F.inp(1);
    float* lut = (float*)(F.lds + AL_LUT); float* kml = (float*)(F.lds + AL_KM); unsigned* flag = (unsigned*)(F.lds + AL_FLAG); int* tl = (int*)(F.lds + AL_TL);
    const int q0 = qb * 256, wq0 = q0 + wid * 32, tq = wq0 + r32;
    typedef __attribute__((address_space(3))) unsigned short lbf16; typedef __attribute__((address_space(3))) unsigned char lu8;
    lu8* const l3 = (lu8*)F.lds;
    const int vlane = ((4 * hi + ((lane & 15) >> 2)) * VT_PITCH + 16 * ((lane >> 4) & 1) + 4 * (lane & 3)) * 2 + 9216, klane = (r32 * KT_PITCH + 8 * hi) * 2;
    const size_t rowbase = (size_t)b * SEQ;
    const float NINF = -__builtin_inff();
    const float b31 = rel_bias[31 * 8 + h];
    { float lv[2];
#pragma unroll
      for (int j = 0; j < 2; ++j) { const int i = tid + j * NTHR, dist = i - 256; lv[j] = (i < 768 && dist >= 0) ? rel_bias[rel_bucket(dist) * 8 + h] : 0.f; }
#pragma unroll
      for (int j = 0; j < 2; ++j) { const int i = tid + j * NTHR, dist = i - 256; if (i < 768) lut[i] = dist < 0 ? NINF : (lv[j] - b31) * LOG2E; } }
    if (MODE == 0) { const float* KM = (const float*)(F.ws + WS_MASK) + ((size_t)b * NH + h) * 16 * 64;
        for (int i = tid; i < 1024; i += NTHR) kml[i] = ((KM[i] + KM[i + KMP_STRIDE]) + (KM[i + 2 * KMP_STRIDE] + KM[i + 3 * KMP_STRIDE])) * (1.f / 256.f);
        if (tid < 16) flag[tid] = 0u; }
    bf16x8 qf[4];
    { const bf16* qp = Y + (rowbase + tq) * 1024 + 512 + h * 64 + 8 * hi;
#pragma unroll
      for (int ds = 0; ds < 4; ++ds) qf[ds] = *(const bf16x8*)(qp + 16 * ds); }
#ifndef ATT_QLDS
#define ATT_QLDS 0
#endif
    bf16* qs = (bf16*)(F.lds + AL_QS) + (wid * 32 + r32) * 72 + 8 * hi;
    if (ATT_QLDS) {
#pragma unroll
        for (int ds = 0; ds < 4; ++ds) *(bf16x8*)(qs + 16 * ds) = qf[ds]; }
    const int ldr = tid >> 3, ldc = tid & 7;
    const size_t ldoff = (rowbase + ldr) * 512 + h * 64 + ldc * 8;
    const u32x4 k0r = *(const u32x4*)(Kg + ldoff + (size_t)q0 * 512), v0r = *(const u32x4*)(Vg + ldoff + (size_t)q0 * 512);
    const u32x4 k1r = *(const u32x4*)(Kg + ldoff + (size_t)(q0 + 64) * 512), v1r = *(const u32x4*)(Vg + ldoff + (size_t)(q0 + 64) * 512);
    __syncthreads();
    if (dry && ATT_DRY_LEVEL == 3) { __syncthreads(); return; }
    unsigned selmask = 0u;
    if (MODE == 0) {
        const int own = qb;
        float qv[32];
#pragma unroll
        for (int ds = 0; ds < 4; ++ds)
#pragma unroll
            for (int e = 0; e < 8; ++e) qv[8 * ds + e] = bf2f((unsigned short)qf[ds][e]);
        float g[16];
#pragma unroll
        for (int n = 0; n < 16; ++n) { float s = 0.f;
            if (n < own) {
#pragma unroll
                for (int ds = 0; ds < 4; ++ds) { const f32x4 k0 = *(const f32x4*)(kml + n * 64 + 16 * ds + 8 * hi), k1 = *(const f32x4*)(kml + n * 64 + 16 * ds + 8 * hi + 4);
                    s += qv[8 * ds] * k0.x + qv[8 * ds + 1] * k0.y + qv[8 * ds + 2] * k0.z + qv[8 * ds + 3] * k0.w + qv[8 * ds + 4] * k1.x + qv[8 * ds + 5] * k1.y + qv[8 * ds + 6] * k1.z + qv[8 * ds + 7] * k1.w; }
                auto rr = __builtin_amdgcn_permlane32_swap(__float_as_uint(s), __float_as_uint(s), false, false); s = __uint_as_float(rr[0]) + __uint_as_float(rr[1]); }
            g[n] = s; }
#pragma unroll
        for (int n = 0; n < 16; ++n) { int rank = 0;
#pragma unroll
            for (int m = 0; m < 16; ++m) if (m != n) rank += (m < own && (g[m] > g[n] || (g[m] == g[n] && m < n))) ? 1 : 0;
            if (n < own && rank < 3) selmask |= 1u << n; }
#pragma unroll
        for (int n = 0; n < 16; ++n) if (n < own && __builtin_amdgcn_ballot_w64((selmask >> n) & 1u) != 0ull && lane == 0) atomicOr(&flag[n], 1u);
        __syncthreads();
        if (dry && ATT_DRY_LEVEL == 4) { __syncthreads(); return; }
    }
    if (dry && ATT_DRY_LEVEL == 2) { __syncthreads(); return; }
    unsigned bmask;
    { const bool f = lane < qb && (MODE == 1 || (lane < 16 && flag[lane & 15] != 0u)); bmask = (unsigned)__builtin_amdgcn_readfirstlane((int)(unsigned)__builtin_amdgcn_ballot_w64(f)); }
    const int nt = 4 + 4 * __builtin_popcount(bmask);
    int seq_t = 3, seq_b = 0; unsigned seq_rem = bmask;
    auto next_kv = [&]() -> int { int kv; if (seq_t < 4) kv = q0 + 64 * seq_t; else { if ((seq_t & 3) == 0) { seq_b = __builtin_ctz(seq_rem); seq_rem &= seq_rem - 1u; } kv = seq_b * 256 + 64 * (seq_t & 3); } ++seq_t; return kv; };
    int kvq0 = q0, kvq1 = q0 + 64, kvq2 = q0 + 128;
    u32x4 kreg, vreg;
#define ATT_FETCH(kv_) do { kreg = *(const u32x4*)(Kg + ldoff + (size_t)(kv_) * 512); vreg = *(const u32x4*)(Vg + ldoff + (size_t)(kv_) * 512); } while (0)
#define ATT_STAGE(t) do { bf16* Kn_ = (bf16*)(F.lds + AL_KV + ((t) % 3) * AL_KVBUF); *(u32x4*)(Kn_ + ldr * KT_PITCH + ldc * 8) = kreg; *(u32x4*)(Kn_ + 4608 + ldr * VT_PITCH + ldc * 8) = vreg; } while (0)
    kreg = k0r; vreg = v0r; ATT_STAGE(0); kreg = k1r; vreg = v1r; ATT_STAGE(1);
    ATT_FETCH(q0 + 128);
    float m_ref = 0.f, l_run = 0.f; f32x16 o0 = {}, o1 = {};
#define ATT_SPLAT(x) (f32x16){x, x, x, x, x, x, x, x, x, x, x, x, x, x, x, x}
    auto tile_flags = [&](int kv0, bool& sel, unsigned& w0, unsigned& w1) {
        const int blk = kv0 >> 8; sel = true; w0 = 0xffffffffu; w1 = 0xffffffffu;
        if (MODE == 0) { if (blk < qb) sel = (selmask >> blk) & 1u; }
        else { const u32x2 mw = *(const u32x2*)((const unsigned*)(F.ws + WS_MASK) + (rowbase + tq) * 128 + (kv0 >> 5)); w0 = mw.x; w1 = mw.y; } };
#define ATT_QK(t, S0, S1, SEL) do { const lu8* Kt_ = l3 + AL_KV + ((t) % 3) * AL_KVBUF + klane; asm volatile("" : "+v"(Kt_)); S0 = ATT_SPLAT(0.f); S1 = ATT_SPLAT(0.f); \
        bf16x8 kfr_[8]; \
        _Pragma("unroll") for (int ds = 0; ds < 4; ++ds) { kfr_[2 * ds] = *(const __attribute__((address_space(3))) bf16x8*)(Kt_ + 32 * ds); kfr_[2 * ds + 1] = *(const __attribute__((address_space(3))) bf16x8*)(Kt_ + 32 * KT_PITCH * 2 + 32 * ds); } \
        asm volatile("s_waitcnt lgkmcnt(0)" : "+v"(kfr_[0]), "+v"(kfr_[1]), "+v"(kfr_[2]), "+v"(kfr_[3]), "+v"(kfr_[4]), "+v"(kfr_[5]), "+v"(kfr_[6]), "+v"(kfr_[7]));     \
        _Pragma("unroll") for (int ds = 0; ds < 4; ++ds) { \
            const bf16x8 q_ = ATT_QLDS ? *(const bf16x8*)(qs + 16 * ds) : qf[ds]; \
            S0 = __builtin_amdgcn_mfma_f32_32x32x16_bf16(kfr_[2 * ds], q_, S0, 0, 0, 0); S1 = __builtin_amdgcn_mfma_f32_32x32x16_bf16(kfr_[2 * ds + 1], q_, S1, 0, 0, 0); } \
        asm volatile("s_nop 15\n\ts_nop 7" : "+v"(S0), "+v"(S1)); } while (0)
#define ATT_VLOAD(VT) do { const lu8* vb3 = l3 + AL_KV + ((VT) % 3) * AL_KVBUF + vlane; asm volatile("" : "+v"(vb3)); \
          _Pragma("unroll") for (int st = 0; st < 4; ++st) { const lu8* vb = vb3 + 16 * st * VT_PITCH * 2; \
              vfr[4 * st] = __builtin_bit_cast(bf16x4, __builtin_amdgcn_ds_read_tr16_b64_v4i16((lds_v4p)(vb))); \
              vfr[4 * st + 1] = __builtin_bit_cast(bf16x4, __builtin_amdgcn_ds_read_tr16_b64_v4i16((lds_v4p)(vb + 8 * VT_PITCH * 2))); \
              vfr[4 * st + 2] = __builtin_bit_cast(bf16x4, __builtin_amdgcn_ds_read_tr16_b64_v4i16((lds_v4p)(vb + 64))); \
              vfr[4 * st + 3] = __builtin_bit_cast(bf16x4, __builtin_amdgcn_ds_read_tr16_b64_v4i16((lds_v4p)(vb + 8 * VT_PITCH * 2 + 64))); } } while (0)
#define ATT_BIAS(kv_, S0, S1) do { if ((kv_) >= q0 - 256) { const float* lp_ = lut + (tq - (kv_) + 256); \
        _Pragma("unroll") for (int r = 0; r < 16; ++r) { const int kr_ = crow(r, hi); S0[r] += lp_[-kr_]; S1[r] += lp_[-kr_ - 32]; } } } while (0)
    auto row_max = [&](bool sel, f32x16& S0, f32x16& S1) -> float {
        float mx = max3_f(S0[0], S0[1], S0[2]);
#pragma unroll
        for (int r = 3; r < 15; r += 2) mx = max3_f(mx, S0[r], S0[r + 1]);
#pragma unroll
        for (int r = 0; r < 16; r += 2) mx = max3_f(mx, S1[r], S1[r + 1]);
        mx = max3_f(mx, S0[15], S0[15]);
        auto rr = __builtin_amdgcn_permlane32_swap(__float_as_uint(mx), __float_as_uint(mx), false, false); return max3_f(__uint_as_float(rr[0]), __uint_as_float(rr[1]), __uint_as_float(rr[1])); };
    f32x16 sc0, sc1, sn0 = {}, sn1 = {};
    bool sel_c, sel_n = true; unsigned mwc0, mwc1, mwn0 = 0u, mwn1 = 0u;
    __syncthreads();
    tile_flags(q0, sel_c, mwc0, mwc1);
    bf16x4 vfr[16];
    { ATT_QK(0, sc0, sc1, sel_c); ATT_BIAS(q0, sc0, sc1); const float mx = row_max(sel_c, sc0, sc1);
      if (__builtin_amdgcn_ballot_w64(mx > 8.0f) != 0ull) { const float dl = mx > 0.f ? mx : 0.f; m_ref += dl;
#pragma unroll
          for (int r = 0; r < 16; ++r) { sc0[r] -= dl; sc1[r] -= dl; } } }
#pragma unroll 1
    for (int i = 0; i < nt; ++i) {
        if (PROF != 5) __syncthreads();
        int kv3 = 0;
        if (i + 2 < nt) { ATT_STAGE(i + 2); if (i + 3 < nt) { kv3 = next_kv(); ATT_FETCH(kv3); } }
        const int tn = i + 1 < nt ? i + 1 : i;
        const int kvn = i + 1 < nt ? kvq1 : kvq0;
        tile_flags(kvn, sel_n, mwn0, mwn1);
        if (PROF != 3) ATT_QK(tn, sn0, sn1, sel_n);
        if (PROF != 2) ATT_VLOAD(i);
        float ps = 0.f;
#pragma unroll
        for (int r = 0; r < 16; ++r) { float p0 = PROF == 1 ? sc0[r] * 0.5f : __builtin_amdgcn_exp2f(sc0[r]), p1 = PROF == 1 ? sc1[r] * 0.5f : __builtin_amdgcn_exp2f(sc1[r]);
            if (MODE == 1) { const int kr = crow(r, hi);
                p0 = __uint_as_float(__float_as_uint(p0) & (unsigned)__builtin_amdgcn_sbfe((int)mwc0, kr, 1)); p1 = __uint_as_float(__float_as_uint(p1) & (unsigned)__builtin_amdgcn_sbfe((int)mwc1, kr, 1)); }
            sc0[r] = p0; sc1[r] = p1; ps += p0 + p1; }
        u32x4 pw0 = {pk2(sc0[0], sc0[1]), pk2(sc0[2], sc0[3]), pk2(sc0[4], sc0[5]), pk2(sc0[6], sc0[7])};
        u32x4 pw1 = {pk2(sc0[8], sc0[9]), pk2(sc0[10], sc0[11]), pk2(sc0[12], sc0[13]), pk2(sc0[14], sc0[15])};
        u32x4 pw2 = {pk2(sc1[0], sc1[1]), pk2(sc1[2], sc1[3]), pk2(sc1[4], sc1[5]), pk2(sc1[6], sc1[7])};
        u32x4 pw3 = {pk2(sc1[8], sc1[9]), pk2(sc1[10], sc1[11]), pk2(sc1[12], sc1[13]), pk2(sc1[14], sc1[15])};
        if (MODE == 0) { const unsigned sm = sel_c ? 0xffffffffu : 0u; ps = sel_c ? ps : 0.f;
            pw0.x &= sm; pw0.y &= sm; pw0.z &= sm; pw0.w &= sm; pw1.x &= sm; pw1.y &= sm; pw1.z &= sm; pw1.w &= sm;
            pw2.x &= sm; pw2.y &= sm; pw2.z &= sm; pw2.w &= sm; pw3.x &= sm; pw3.y &= sm; pw3.z &= sm; pw3.w &= sm; }
        l_run += ps;
        if (PROF != 3) ATT_BIAS(kvn, sn0, sn1);
        if (PROF != 2) {
          asm volatile("s_waitcnt lgkmcnt(0)" : "+v"(vfr[0]), "+v"(vfr[1]), "+v"(vfr[2]), "+v"(vfr[3]), "+v"(vfr[4]), "+v"(vfr[5]), "+v"(vfr[6]), "+v"(vfr[7]), "+v"(vfr[8]), "+v"(vfr[9]), "+v"(vfr[10]), "+v"(vfr[11]), "+v"(vfr[12]), "+v"(vfr[13]), "+v"(vfr[14]), "+v"(vfr[15]));
#pragma unroll
          for (int st = 0; st < 4; ++st) { const bf16x8 pf = __builtin_bit_cast(bf16x8, st == 0 ? pw0 : (st == 1 ? pw1 : (st == 2 ? pw2 : pw3)));
              const bf16x4 a0 = vfr[4 * st], a1 = vfr[4 * st + 1], c0 = vfr[4 * st + 2], c1 = vfr[4 * st + 3];
              const bf16x8 vf0 = {a0[0], a0[1], a0[2], a0[3], a1[0], a1[1], a1[2], a1[3]}, vf1 = {c0[0], c0[1], c0[2], c0[3], c1[0], c1[1], c1[2], c1[3]};
              o0 = __builtin_amdgcn_mfma_f32_32x32x16_bf16(vf0, pf, o0, 0, 0, 0);
              o1 = __builtin_amdgcn_mfma_f32_32x32x16_bf16(vf1, pf, o1, 0, 0, 0); } }
        float mxn = PROF == 3 ? 0.f : row_max(sel_n, sn0, sn1) - m_ref;
        if (MODE == 0) mxn = sel_n ? mxn : NINF;
        if (i + 1 < nt && __builtin_amdgcn_ballot_w64(mxn > 8.0f) != 0ull) { const float dl = mxn > 0.f ? mxn : 0.f, f = __builtin_amdgcn_exp2f(-dl); m_ref += dl; l_run *= f;
#pragma unroll
            for (int r = 0; r < 16; ++r) { o0[r] *= f; o1[r] *= f; } }
        if (__builtin_amdgcn_ballot_w64(m_ref != 0.f) != 0ull) {
#pragma unroll
            for (int r = 0; r < 16; ++r) { sn0[r] -= m_ref; sn1[r] -= m_ref; } }
        sc0 = sn0; sc1 = sn1; sel_c = sel_n; mwc0 = mwn0; mwc1 = mwn1; kvq0 = kvq1; kvq1 = kvq2; kvq2 = kv3;
    }
#undef ATT_BIAS
#undef ATT_FETCH
#undef ATT_STAGE
#undef ATT_QK
#undef ATT_VLOAD
    { auto rr = __builtin_amdgcn_permlane32_swap(__float_as_uint(l_run), __float_as_uint(l_run), false, false); l_run = __uint_as_float(rr[0]) + __uint_as_float(rr[1]); }
    const float rl = 1.0f / l_run;
    bf16* op = (dry ? (bf16*)(GASP float*)F.out : Y) + (rowbase + tq) * 1024 + 512 + h * 64 + 4 * hi;
#pragma unroll
    for (int rg = 0; rg < 4; ++rg) {
        u32x2 w0, w1; w0.x = pk2(o0[4 * rg] * rl, o0[4 * rg + 1] * rl); w0.y = pk2(o0[4 * rg + 2] * rl, o0[4 * rg + 3] * rl);
        w1.x = pk2(o1[4 * rg] * rl, o1[4 * rg + 1] * rl); w1.y = pk2(o1[4 * rg + 2] * rl, o1[4 * rg + 3] * rl);
        { *(u32x2*)(op + 8 * rg) = w0; *(u32x2*)(op + 32 + 8 * rg) = w1; } }
    __syncthreads();
}

constexpr int CF_IN_ROWS = 62, CF_IN_BYTES = CF_IN_ROWS * 1024, CF_OUT_OFF = 63488;
__device__ __forceinline__ void conformer_unit(Frame& F, int b, int tile) {
    const float* dw_w = F.inp(23); const float* dw_b = F.inp(24); const float* ln_g = F.inp(25); const float* ln_b = F.inp(26);
    const bf16* CP = (const bf16*)(F.ws + WS_XR); bf16* Y = (bf16*)(F.ws + WS_Y);
    unsigned* cin = (unsigned*)F.lds; float* cout = (float*)(F.lds + CF_OUT_OFF);
    const int t0 = tile * 32; const size_t rowbase = (size_t)b * SEQ;
    { u32x4 v[8];
#pragma unroll
      for (int j = 0; j < 8; ++j) { const int i = F.tid + j * NTHR, r = i >> 6, ch = i & 63; const int t = t0 - 30 + r;
          v[j] = (u32x4){0u, 0u, 0u, 0u}; if (i < CF_IN_ROWS * 64 && t >= 0) v[j] = *(const u32x4*)(CP + (rowbase + t) * 512 + ch * 8); }
#pragma unroll
      for (int j = 0; j < 8; ++j) { const int i = F.tid + j * NTHR, r = i >> 6, ch = i & 63; if (i < CF_IN_ROWS * 64) *(u32x4*)(cin + r * 256 + ch * 4) = v[j]; } }
    const int cp = F.tid & 255, th = F.tid >> 8;
    float w0[31], w1[31];
#pragma unroll
    for (int k = 0; k < 31; ++k) { const f32x2 w = *(const f32x2*)(dw_w + k * 512 + 2 * cp); w0[k] = w.x; w1[k] = w.y; }
    const f32x2 bb = *(const f32x2*)(dw_b + 2 * cp);
    __syncthreads();
#pragma unroll 1
    for (int blk = 0; blk < 4; ++blk) { const int tau0 = th * 16 + blk * 4;
        float a0[4], a1[4];
#pragma unroll
        for (int o = 0; o < 4; ++o) { a0[o] = bb.x; a1[o] = bb.y; }
#pragma unroll
        for (int i = 0; i < 34; ++i) { const unsigned v = cin[(tau0 + i) * 256 + cp]; const float lo = bflo(v), hi = bfhi(v);
#pragma unroll
            for (int o = 0; o < 4; ++o) { const int k = i - o; if (k >= 0 && k < 31) { a0[o] += w0[k] * lo; a1[o] += w1[k] * hi; } } }
#pragma unroll
        for (int o = 0; o < 4; ++o) *(f32x2*)(cout + (tau0 + o) * 512 + 2 * cp) = (f32x2){a0[o], a1[o]};
    }
    __syncthreads();
    f32x4 g0 = *(const f32x4*)(ln_g + 8 * F.lane), g1 = *(const f32x4*)(ln_g + 8 * F.lane + 4), be0 = *(const f32x4*)(ln_b + 8 * F.lane), be1 = *(const f32x4*)(ln_b + 8 * F.lane + 4);
#pragma unroll
    for (int i = 0; i < 4; ++i) { const int tok = F.wave * 4 + i;
        f32x4 v0 = *(const f32x4*)(cout + tok * 512 + 8 * F.lane), v1 = *(const f32x4*)(cout + tok * 512 + 8 * F.lane + 4);
        const float mean = wave_sum((v0.x + v0.y) + (v0.z + v0.w) + (v1.x + v1.y) + (v1.z + v1.w)) * (1.f / 512.f);
        v0 = v0 - mean; v1 = v1 - mean;
        const float var = wave_sum((v0.x * v0.x + v0.y * v0.y) + (v0.z * v0.z + v0.w * v0.w) + (v1.x * v1.x + v1.y * v1.y) + (v1.z * v1.z + v1.w * v1.w)) * (1.f / 512.f);
        const float rstd = __builtin_amdgcn_rsqf(var + pg8::NORM_EPS);
        v0 = v0 * rstd * g0 + be0; v1 = v1 * rstd * g1 + be1;
#pragma unroll
        for (int e = 0; e < 4; ++e) { v0[e] = v0[e] * pg8::sigmoid_f(v0[e]); v1[e] = v1[e] * pg8::sigmoid_f(v1[e]); }
        *(u32x4*)(Y + (rowbase + t0 + tok) * 1024 + 8 * F.lane) = pg8::pack8(v0, v1); }
    __syncthreads();
}

constexpr int SEL_CAP = 160, QI_PITCH = 520, NBIN = 384, HROW = 385;
constexpr int SL_HIST = 0, SL_CV = 32 * HROW * 4 + 64, SL_CI = SL_CV + 32 * SEL_CAP * 4, SL_MASK = SL_CI + 32 * SEL_CAP * 4, SL_CNT = SL_MASK + 16384, SL_THR = SL_CNT + 128, SL_CAB = SL_THR + 128, SL_QI = SL_CAB + 128, SL_WQ = SL_QI + 32 * QI_PITCH * 2, SL_END = SL_WQ + 32 * 8 * 4;
static_assert(SL_END <= 147392 && SL_QI % 16 == 0, "select LDS");
__device__ __forceinline__ int sel_binoff(float v) {
    const int bits = (int)__float_as_uint(v); int mag = (int)(((unsigned)bits >> 19) & 0xfffu) - (121 << 4);
    mag = mag < 0 ? 0 : (mag > 191 ? 191 : mag);
    return mag ^ (bits >> 31);
}
__device__ __forceinline__ float relu_f(float x) { const int xi = (int)__float_as_uint(x); return __uint_as_float((unsigned)(xi < 0 ? 0 : xi)); }
__device__ __forceinline__ unsigned long long sel_key64(float v, unsigned idx) { const unsigned u = __float_as_uint(v); const unsigned key = u ^ ((unsigned)((int)u >> 31) | 0x80000000u);
    return ((unsigned long long)key << 32) | (unsigned long long)(~idx); }
template <int PASS, bool DIAG>
__device__ __forceinline__ void sel_tile(const bf16x8 (&kf)[4], const bf16* qlp, const float (&wreg)[8], unsigned* histq, int thro, unsigned* cntq, float* cvq, unsigned* ciq, unsigned* maskq, int jt, int tq, int hi) {
    f32x16 isc = {};
    const __attribute__((address_space(3))) unsigned char* ql3 = (const __attribute__((address_space(3))) unsigned char*)qlp; asm volatile("" : "+v"(ql3));
    typedef const __attribute__((address_space(3))) bf16x8* lq8p;
#define SEL_QLD(dst, hh) do { _Pragma("unroll") for (int ds = 0; ds < 4; ++ds) dst[ds] = *(lq8p)(ql3 + 128 * (hh) + 32 * ds); } while (0)
#define SEL_CHAIN(S, q) do { S = __builtin_amdgcn_mfma_f32_32x32x16_bf16(kf[0], q[0], (f32x16){}, 0, 0, 0); _Pragma("unroll") for (int ds = 1; ds < 4; ++ds) S = __builtin_amdgcn_mfma_f32_32x32x16_bf16(kf[ds], q[ds], S, 0, 0, 0); } while (0)
#define SEL_ACC(S, hh) do { const float w = wreg[hh]; _Pragma("unroll") for (int r = 0; r < 16; ++r) { const float rl = relu_f(S[r]); asm("v_fmac_f32 %0, %1, %2" : "+v"(isc[r]) : "v"(rl), "v"(w)); } } while (0)
    bf16x8 qa[4], qb[4]; f32x16 sA, sB;
    SEL_QLD(qa, 0); SEL_QLD(qb, 1);
    SEL_CHAIN(sA, qa);
#pragma unroll
    for (int hh = 0; hh < 8; hh += 2) {
        SEL_CHAIN(sB, qb); if (hh + 2 < 8) SEL_QLD(qa, hh + 2);
        __builtin_amdgcn_sched_barrier(0);
        SEL_ACC(sA, hh);
        __builtin_amdgcn_sched_barrier(0);
        if (hh + 2 < 8) { SEL_CHAIN(sA, qa); if (hh + 3 < 8) SEL_QLD(qb, hh + 3); }
        __builtin_amdgcn_sched_barrier(0);
        SEL_ACC(sB, hh + 1);
        __builtin_amdgcn_sched_barrier(0);
    }
#undef SEL_QLD
#undef SEL_CHAIN
#undef SEL_ACC
#ifndef SEL_PROF
#define SEL_PROF 0
#endif
    if (PASS == 2) {
        float dsum = 0.f; int bsum = 0;
#pragma unroll
        for (int r = 0; r < 16; ++r) { if (SEL_PROF <= 1) bsum += sel_binoff(isc[r]); else dsum += isc[r]; }
        if (dsum == 123.456f || bsum == 0x7fffffff) histq[0] = 1u;
        return; }
    if (PASS == 3) {
        unsigned part = 0u;
#pragma unroll
        for (int r = 0; r < 16; ++r) { const int kr = crow(r, hi), kv = jt * 32 + kr; const bool valid = !DIAG || kv <= tq; const int bo = sel_binoff(isc[r]);
            if (SEL_PROF == 4) { if (valid && bo > thro) part |= 1u << kr; }
            else { if (valid && bo == thro) { const unsigned idx = atomicAdd(cntq, 1u); if (idx < (unsigned)SEL_CAP) { ((unsigned long long*)cvq)[idx] = sel_key64(isc[r], (unsigned)kv); } } } }
        if (SEL_PROF == 4) { auto rr = __builtin_amdgcn_permlane32_swap(part, part, false, false); const unsigned word = rr[0] | rr[1]; if (hi == 0) maskq[jt] = word; }
        return; }
    unsigned part = 0u;
#pragma unroll
    for (int r = 0; r < 16; ++r) { const int kr = crow(r, hi), kv = jt * 32 + kr; const bool valid = !DIAG || kv <= tq; const int bo = sel_binoff(isc[r]);
        if (PASS == 0) { if (valid) atomicAdd(histq + bo, 1u); }
        else { if (valid && bo > thro) part |= 1u << kr;
               if (valid && bo == thro) { const unsigned idx = atomicAdd(cntq, 1u); if (idx < (unsigned)SEL_CAP) { ((unsigned long long*)cvq)[idx] = sel_key64(isc[r], (unsigned)kv); } } } }
    if (PASS == 1) { auto rr = __builtin_amdgcn_permlane32_swap(part, part, false, false); const unsigned word = rr[0] | rr[1]; if (hi == 0) maskq[jt] = word; }
}
template <int PASS>
__device__ __forceinline__ void sel_pass(Frame& F, const bf16* KI, size_t rowbase, int qg, const bf16* qlp, const float* wql, unsigned* histq, int thro, unsigned* cntq, float* cvq, unsigned* ciq, unsigned* maskq, int tq) {
    const int lane = F.lane, wid = F.wave, r32 = lane & 31, hi = lane >> 5;
    float wreg[8];
    { const f32x4 w0 = *(const f32x4*)wql, w1 = *(const f32x4*)(wql + 4); wreg[0] = w0.x; wreg[1] = w0.y; wreg[2] = w0.z; wreg[3] = w0.w; wreg[4] = w1.x; wreg[5] = w1.y; wreg[6] = w1.z; wreg[7] = w1.w; }
    bf16x8 kn[4];
    if (wid <= qg) { const bf16* kp = KI + (rowbase + wid * 32 + r32) * 64 + 8 * hi;
#pragma unroll
        for (int ds = 0; ds < 4; ++ds) kn[ds] = *(const bf16x8*)(kp + 16 * ds); }
#pragma unroll 1
    for (int jt = wid; jt <= qg; jt += NWAVES) {
        bf16x8 kf[4];
#pragma unroll
        for (int ds = 0; ds < 4; ++ds) kf[ds] = kn[ds];
        if (jt + NWAVES <= qg) { const bf16* kp = KI + (rowbase + (jt + NWAVES) * 32 + r32) * 64 + 8 * hi;
#pragma unroll
            for (int ds = 0; ds < 4; ++ds) kn[ds] = *(const bf16x8*)(kp + 16 * ds); }
        if (jt < qg) sel_tile<PASS, false>(kf, qlp, wreg, histq, thro, cntq, cvq, ciq, maskq, jt, tq, hi);
        else sel_tile<PASS, true>(kf, qlp, wreg, histq, thro, cntq, cvq, ciq, maskq, jt, tq, hi);
    }
}
#ifndef SEL_DRY_LEVEL
#define SEL_DRY_LEVEL 1
#endif
__device__ __forceinline__ void dsa_select_unit(Frame& F, int b, int qg, int dry) {
    if (dry && SEL_DRY_LEVEL >= 9) return;
    const int lane = F.lane, wid = F.wave, r32 = lane & 31, hi = lane >> 5;
    const bf16* QI = (const bf16*)(F.ws + WS_QI); const bf16* KI = (const bf16*)(F.ws + WS_KI); const float* WI = (const float*)(F.ws + WS_WI);
    unsigned* MASK = (unsigned*)(F.ws + WS_MASK);
    unsigned* hist = (unsigned*)(F.lds + SL_HIST);
    float* cv = (float*)(F.lds + SL_CV); unsigned* ci = (unsigned*)(F.lds + SL_CI); unsigned* maskl = (unsigned*)(F.lds + SL_MASK);
    unsigned* cnt = (unsigned*)(F.lds + SL_CNT); int* thr = (int*)(F.lds + SL_THR); int* cab = (int*)(F.lds + SL_CAB);
    const size_t rowbase = (size_t)b * SEQ; const int tq = qg * 32 + r32;
    bf16* qil = (bf16*)(F.lds + SL_QI);
    u32x4 qv[4];
#pragma unroll
    for (int u = 0; u < 4; ++u) { const int i = F.tid + u * NTHR; qv[u] = *(const u32x4*)(QI + (rowbase + qg * 32 + (i >> 6)) * 512 + (i & 63) * 8); }
    for (int i = F.tid; i < 32 * HROW / 4; i += NTHR) ((u32x4*)hist)[i] = (u32x4){0u, 0u, 0u, 0u};
    for (int i = F.tid; i < 32 * 128 / 4; i += NTHR) ((u32x4*)maskl)[i] = (u32x4){0u, 0u, 0u, 0u};
    if (F.tid < 32) cnt[F.tid] = 0u;
#pragma unroll
    for (int u = 0; u < 4; ++u) { const int i = F.tid + u * NTHR; *(u32x4*)(qil + (i >> 6) * QI_PITCH + (i & 63) * 8) = qv[u]; }
    float* wql = (float*)(F.lds + SL_WQ) + r32 * 8;
    if (F.tid < 64) { const int r = F.tid >> 1, hf = F.tid & 1; *(f32x4*)((float*)(F.lds + SL_WQ) + r * 8 + hf * 4) = *(const f32x4*)(WI + (rowbase + qg * 32 + r) * 8 + hf * 4); }
    const bf16* qlp = qil + r32 * QI_PITCH + 8 * hi;
    unsigned* histq = hist + r32 * HROW + 192;
    __syncthreads();
    if (dry && SEL_DRY_LEVEL >= 5) { sel_pass<2>(F, KI, rowbase, qg, qlp, wql, histq, 0, cnt + r32, cv + r32 * SEL_CAP * 2, ci, maskl + r32 * 128, tq); __syncthreads(); return; }
    if (dry && SEL_DRY_LEVEL >= 4) { __syncthreads(); return; }
    sel_pass<0>(F, KI, rowbase, qg, qlp, wql, histq, 0, cnt + r32, cv + r32 * SEL_CAP * 2, ci, maskl + r32 * 128, tq);
    __syncthreads();
#pragma unroll
    for (int i = 0; i < 4; ++i) { const int q = wid * 4 + i; const int tqq = qg * 32 + q;
        const unsigned* hq = hist + q * HROW + lane * 6;
        int c[6]; c[0] = hq[0]; c[1] = hq[1]; c[2] = hq[2]; c[3] = hq[3]; c[4] = hq[4]; c[5] = hq[5];
        int tot = 0;
#pragma unroll
        for (int k = 0; k < 6; ++k) tot += c[k];
        int incl = tot;
#pragma unroll
        for (int o = 1; o < 64; o <<= 1) { const int v = __shfl_down(incl, o); if (lane + o < 64) incl += v; }
        const int above = incl - tot;
        if (tqq + 1 <= 256) { if (lane == 0) { thr[q] = -1000; cab[q] = 0; } }
        else if (above < 256 && above + tot >= 256) {
            int bsel = 0, ab = above, csel = 0;
#pragma unroll
            for (int k = 5; k >= 0; --k) { if (ab < 256 && ab + c[k] >= 256) { bsel = lane * 6 + k; csel = c[k]; break; } ab += c[k]; }
            if (csel > SEL_CAP) { thr[q] = bsel - 193; cab[q] = 256; }
            else { thr[q] = bsel - 192; cab[q] = ab; } }
    }
    __syncthreads();
    if (dry && SEL_DRY_LEVEL >= 3) { if (SEL_PROF >= 4) sel_pass<3>(F, KI, rowbase, qg, qlp, wql, histq, thr[r32], cnt + r32, cv + r32 * SEL_CAP * 2, ci, maskl + r32 * 128, tq); __syncthreads(); return; }
    sel_pass<1>(F, KI, rowbase, qg, qlp, wql, histq, thr[r32], cnt + r32, cv + r32 * SEL_CAP * 2, ci, maskl + r32 * 128, tq);
    __syncthreads();
    if (dry && SEL_DRY_LEVEL >= 2) { __syncthreads(); return; }
#pragma unroll 1
    for (int i = 0; i < 4; ++i) { const int q = wid * 4 + i; const int tb = thr[q];
        if (tb > -1000) { const int nc = min((int)cnt[q], SEL_CAP), need = 256 - cab[q]; const int nc4 = (nc + 3) & ~3;
            unsigned long long* cq = (unsigned long long*)cv + q * SEL_CAP;
            for (int k = nc + lane; k < nc4; k += 64) cq[k] = 0ull;
            asm volatile("s_waitcnt lgkmcnt(0)" ::: "memory");
            for (int a0 = 0; a0 < nc; a0 += 64) { const int a = a0 + lane; const bool act = a < nc;
                const unsigned long long ka = act ? cq[a] : 0ull; int rank = 0;
#pragma unroll 2
                for (int k = 0; k < nc4; k += 4) { const u32x4 c01 = *(const u32x4*)(cq + k), c23 = *(const u32x4*)(cq + k + 2);
                    rank += ((((unsigned long long)c01.y << 32) | c01.x) > ka) ? 1 : 0; rank += ((((unsigned long long)c01.w << 32) | c01.z) > ka) ? 1 : 0;
                    rank += ((((unsigned long long)c23.y << 32) | c23.x) > ka) ? 1 : 0; rank += ((((unsigned long long)c23.w << 32) | c23.z) > ka) ? 1 : 0; }
                const unsigned ia = ~(unsigned)ka;
                if (act && rank < need) atomicOr(&maskl[q * 128 + (ia >> 5)], 1u << (ia & 31)); } } }
    __syncthreads();
    if (!dry) for (int i = F.tid; i < 32 * 128; i += NTHR) MASK[(rowbase + qg * 32 + (i >> 7)) * 128 + (i & 127)] = maskl[i];
    __syncthreads();
}

__device__ __forceinline__ int lane_id() { int l; asm volatile("v_mbcnt_lo_u32_b32 %0, -1, 0\n\tv_mbcnt_hi_u32_b32 %0, -1, %0" : "=v"(l)); return l; }
#define LAS __attribute__((address_space(3)))
constexpr int CW_BAR_BYTES = 16384;
constexpr int MISC_OFF = LDS_BYTES - 64;
#define XB_TMO      128
#define XB_XCNT(j)  (256  + 64 * (j))
#define XB_XSUB(j)  (1280 + 64 * (j))
#define XB_XGEN(j)  (2304 + 64 * (j))
#define XB_TOP      3328
#define XB_TOPGEN   3392
#define XCD_BAR_WORDS 3456
#define XB_SPIN_CAP (1u << 18)

__device__ __forceinline__ unsigned xb_ld(unsigned* p)              { return __hip_atomic_load(p, __ATOMIC_RELAXED, __HIP_MEMORY_SCOPE_AGENT); }
__device__ __forceinline__ unsigned xb_add(unsigned* p, unsigned v) { return __hip_atomic_fetch_add(p, v, __ATOMIC_RELAXED, __HIP_MEMORY_SCOPE_AGENT); }
__device__ __forceinline__ unsigned xb_xcc_id() { return (unsigned)__builtin_amdgcn_s_getreg((3 << 11) | 20) & 0xFu; }
#define XB_SPIN(cond, bar) do { unsigned _sp = 0; while (cond) { __builtin_amdgcn_s_sleep(1); \
    if ((++_sp & 255u) == 0u) { if (xb_ld(&(bar)[XB_TMO])) break; if (_sp > XB_SPIN_CAP) { atomicAdd(&(bar)[XB_TMO], 1u); break; } } } } while (0)

struct XcdBarrier {
    unsigned* bar; unsigned x;
    volatile LAS unsigned* st;
};

__device__ __forceinline__ XcdBarrier xcd_barrier_post(unsigned* bar, volatile LAS unsigned* st, bool leader) {
    XcdBarrier b; b.bar = bar; b.x = xb_xcc_id(); b.st = st;
    if (leader) (void)xb_add(&bar[XB_XCNT(b.x)], 1u);
    return b;
}
__device__ __forceinline__ void xcd_barrier_complete(unsigned* bar, unsigned x, unsigned& nloc, unsigned& nx) {
    const unsigned G = gridDim.x * gridDim.y * gridDim.z;
    unsigned sum, cnt, mine, sp = 0u;
    for (;;) {
        sum = 0u; cnt = 0u; mine = 0u;
#pragma unroll
        for (unsigned j = 0; j < 16; ++j) { const unsigned c = xb_ld(&bar[XB_XCNT(j)]); sum += c; cnt += (c > 0u) ? 1u : 0u; mine = (j == x) ? c : mine; }
        if (sum == G) break;
        __builtin_amdgcn_s_sleep(1);
        if ((++sp & 255u) == 0u) { if (xb_ld(&bar[XB_TMO])) break; if (sp > XB_SPIN_CAP) { atomicAdd(&bar[XB_TMO], 1u); break; } }
    }
    nloc = mine > 0u ? mine : 1u; nx = cnt > 0u ? cnt : 1u;
}

__device__ __forceinline__ void xcd_barrier(const XcdBarrier& b, bool leader) {
    asm volatile("s_waitcnt vmcnt(0)" ::: "memory");
    __syncthreads();
    if (leader) {
        unsigned* bar = b.bar;
        __builtin_amdgcn_s_waitcnt(0);
        unsigned nloc = b.st[0], nx = b.st[1];
        if (nloc == 0u) { xcd_barrier_complete(bar, b.x, nloc, nx); b.st[0] = nloc; b.st[1] = nx; }
        const unsigned old = xb_add(&bar[XB_XSUB(b.x)], 1u);
        const unsigned gen = old / nloc;
        if (old + 1u == (gen + 1u) * nloc) {
            __builtin_amdgcn_fence(__ATOMIC_RELEASE, "agent");
            asm volatile("s_waitcnt vmcnt(0)" ::: "memory");
            const unsigned og = xb_add(&bar[XB_TOP], 1u);
            const unsigned tg = og / nx;
            if (og + 1u == (tg + 1u) * nx) xb_add(&bar[XB_TOPGEN], 1u);
            else XB_SPIN(xb_ld(&bar[XB_TOPGEN]) == tg, bar);
            __builtin_amdgcn_fence(__ATOMIC_ACQUIRE, "agent");
            xb_add(&bar[XB_XGEN(b.x)], 1u);
            asm volatile("s_waitcnt vmcnt(0)" ::: "memory");
        } else {
            XB_SPIN(xb_ld(&bar[XB_XGEN(b.x)]) == gen, bar);
            __builtin_amdgcn_fence(__ATOMIC_ACQUIRE, "agent");
            asm volatile("s_waitcnt vmcnt(0)" ::: "memory");
        }
    }
    __syncthreads();
}


#ifndef KMASK
#define KMASK 0xFFFF
#endif
#define KEN(x) (((KMASK) >> (x)) & 1)
#ifndef ATT_PROF
#define ATT_PROF 0
#endif
#ifndef DUP_KIND
#define DUP_KIND -1
#endif
#ifndef DUP_N
#define DUP_N 1
#endif
#define REP(k, dryv) for (int dryv = (DUP_KIND == (k)) ? DUP_N : 0; dryv >= 0; --dryv)
constexpr int N_PHASES = 17;
#ifndef MK_STOP_AFTER
#define MK_STOP_AFTER N_PHASES
#endif
#ifndef MK_COOP
#define MK_COOP 0
#endif

__global__ void __launch_bounds__(NTHR, 2) mega_fwd(Args args) {
    extern __shared__ __attribute__((aligned(16))) unsigned char lds[];
    Frame F;
    const int wv0 = __builtin_amdgcn_readfirstlane((int)threadIdx.x >> 6);
#define MYTID() (wv0 * 64 + lane_id())
    F.lds = lds; F.tid = MYTID(); F.lane = F.tid & 63; F.wave = wv0;
    F.G = gridDim.x; F.bid = blockIdx.x; F.ws = (unsigned char*)(GASP unsigned char*)args.ws; F.in = args.in; F.out = (float*)(GASP float*)args.out;
    cg::grid_group grid = cg::this_grid();
    PG8_LAS unsigned char* glds = (PG8_LAS unsigned char*)lds;
#if MK_COOP
    constexpr int lo = 0, hi = MK_STOP_AFTER;
#else
    const int lo = args.ph_lo, hi = args.ph_hi;
#endif
#define IN(k) (lo <= (k) && (k) < hi)
    volatile LAS unsigned* stw = (volatile LAS unsigned*)((LAS unsigned char*)lds + MISC_OFF);
    if (MYTID() < 2) stw[MYTID()] = 0u;
    __syncthreads();
    XcdBarrier bar; bar.bar = (unsigned*)(args.ws + CW_BAR_BYTES); bar.x = 0; bar.st = stw;
    if (MK_COOP) bar = xcd_barrier_post((unsigned*)((GASP unsigned char*)args.ws + CW_BAR_BYTES), stw, MYTID() == 0);
    if (args.coop == 2) grid.sync();
#ifndef PRB_A
#define PRB_A -1
#endif
#ifndef PRB_B
#define PRB_B -1
#endif
    unsigned long long prb_t0 = 0;
#define STAMP(pt) do { if (PRB_A >= 0) { const int pt_ = (pt); if (pt_ == PRB_A) prb_t0 = __builtin_amdgcn_s_memrealtime(); if (pt_ == PRB_B) { const unsigned long long t1_ = __builtin_amdgcn_s_memrealtime(), w_ = (t1_ - prb_t0) * 4ull; while (__builtin_amdgcn_s_memrealtime() - t1_ < w_) __builtin_amdgcn_s_sleep(4); } } } while (0)
#define SEAM(k) do { STAMP(2 * (k) + 1); if (IN(k) && IN((k) + 1)) { XcdBarrier b2_ = bar; unsigned long long bp_ = (unsigned long long)b2_.bar; asm volatile("" : "+s"(bp_), "+s"(b2_.x)); b2_.bar = (unsigned*)(GASP unsigned*)bp_; xcd_barrier(b2_, MYTID() == 0); } STAMP(2 * (k) + 2); } while (0)

    STAMP(0);
    if (KEN(0) && IN(0)) { REP(0, dry) p0_prologue(F); }
    SEAM(0);
#pragma unroll 1
    for (int l = 0; l < 2; ++l) {
        const int pb = 1 + 8 * l;
#define LAUNDER() unsigned long long wsi_ = (unsigned long long)args.ws, outi_ = (unsigned long long)args.out; asm volatile("" : "+s"(wsi_), "+s"(outi_)); \
        unsigned char* ws = (unsigned char*)(GASP unsigned char*)wsi_; float* outp = (float*)(GASP float*)outi_; \
        unsigned long long* RS = (unsigned long long*)(ws + WS_RS); bf16* XB = (bf16*)(ws + WS_XB); bf16* HB = (bf16*)(ws + WS_H); bf16* Y = (bf16*)(ws + WS_Y); \
        const float* xin = (l == 0) ? F.inp(0) : outp; (void)RS; (void)XB; (void)HB; (void)Y; (void)xin; F.ws = ws; F.out = outp; \
        { int wl_ = wv0; asm volatile("" : "+s"(wl_)); int tl_ = wl_ * 64 + lane_id(); asm volatile("" : "+v"(tl_)); F.tid = tl_; F.lane = tl_ & 63; F.wave = wl_; \
          int bl_ = blockIdx.x, gl_ = gridDim.x; asm volatile("" : "+s"(bl_), "+s"(gl_)); F.bid = bl_; F.G = gl_; }
        if (KEN(1) && IN(pb + 0)) { LAUNDER(); pg8::Gemm g{XB, (const pg8::bf16_t*)(ws + WS_GU0 + (size_t)(2 * l) * SZ_GU), MT, 5632, 1024}; pg8::StaticOrder S; S.init(MT, 5632, F.G, F.bid);
            pg8::EpiGU E{HB, FF, RS + (size_t)(3 * l) * MT, 0};
            REP(1, dry) { E.dry = dry; pg8::gemm_phase<pg8::EpiGU, pg8::StaticOrder, true, true>(glds, g, S, E, F.tid); }
            if (F.G == 256 && F.bid >= 128) conv_items(F, l ? CV_T7 : CV_P, l ? CV_T9 : CV_T1, (F.bid - 128) * NWAVES + F.wave, 128 * NWAVES); }
        SEAM(pb + 0);
        if (KEN(2) && IN(pb + 1)) { LAUNDER(); pg8::Gemm g{HB, (const pg8::bf16_t*)(ws + WS_DN0 + (size_t)(2 * l) * SZ_DN), MT, 1024, FF}; pg8::StaticOrder S; S.init(MT, 1024, F.G, F.bid);
            pg8::EpiRes E{XB, nullptr, RS + (size_t)(3 * l + 1) * MT, 0.5f, 0};
            REP(2, dry) { E.dry = dry; pg8::gemm_phase<pg8::EpiRes, pg8::StaticOrder, true, true>(glds, g, S, E, F.tid); } }
        SEAM(pb + 1);
        if (KEN(3) && IN(pb + 2)) { LAUNDER(); const int N = l ? 3328 : 2560; pg8::Gemm g{XB, (const pg8::bf16_t*)(ws + (l ? WS_WIN1 : WS_WIN0)), MT, N, 1024}; pg8::StaticOrder S; S.init(MT, N, F.G, F.bid);
            pg8::EpiMix E{RS + (size_t)(3 * l + 1) * MT, l, Y, (bf16*)(ws + WS_XR), (bf16*)(ws + WS_K), (bf16*)(ws + WS_V), (bf16*)(ws + WS_QI), (bf16*)(ws + WS_KI),
                          F.inp(l ? 27 : 19), F.inp(l ? 28 : 20), QSCALE, (float*)(ws + WS_WI), IDX_SCALE};
            REP(3, dry) pg8::gemm_phase<pg8::EpiMix, pg8::StaticOrder, true, true>(glds, g, S, E, F.tid);
            if (F.G == 256 && l == 0 && F.bid >= 128) conv_items(F, CV_T1, CV_T3, (F.bid - 128) * NWAVES + F.wave, 128 * NWAVES);
            if (F.G == 256 && l == 1 && F.bid >= 64) conv_items(F, CV_T9, CV_T11, (F.bid - 64) * NWAVES + F.wave, 192 * NWAVES); }
        SEAM(pb + 2);
        if (IN(pb + 3)) { LAUNDER();
            if (l == 0) { if (KEN(4)) REP(4, dry) for (int u = F.bid; u < 256; u += F.G) lru_unit(F, u >> 6, u & 63, 0, dry);
                          if (KEN(5)) REP(5, dry) for (int u = F.bid; u < 256; u += F.G) kmean_unit(F, u >> 6, (u >> 2) & 15, u & 3); }
            else { if (KEN(6)) REP(6, dry) for (int u = F.bid; u < 256; u += F.G) { const int b = u >> 6, s = u & 63; dsa_select_unit(F, b, s, dry); dsa_select_unit(F, b, 127 - s, dry); }
                   if (KEN(7)) REP(7, dry) for (int u = F.bid; u < 512; u += F.G) conformer_unit(F, u >> 7, u & 127); }
        }
        SEAM(pb + 3);
        if (IN(pb + 4)) { LAUNDER();
            for (int u = F.bid; u < 256; u += F.G) { const int bh = u >> 3, s = u & 7;
                if (l == 0) { if (KEN(8)) REP(8, dry) { attn_unit<0>(F, bh >> 3, bh & 7, 15 - s, dry); attn_unit<0>(F, bh >> 3, bh & 7, s, dry); } }
                else { if (KEN(9)) REP(9, dry) { attn_unit<1>(F, bh >> 3, bh & 7, 15 - s, dry); attn_unit<1>(F, bh >> 3, bh & 7, s, dry); } } }
            if (KEN(10) && l == 0) REP(10, dry) for (int u = F.bid; u < 256; u += F.G) lru_unit(F, u >> 6, u & 63, 1, dry);
        }
        SEAM(pb + 4);
        if (KEN(2) && IN(pb + 5)) { LAUNDER(); pg8::Gemm g{Y, (const pg8::bf16_t*)(ws + (l ? WS_WOUT1 : WS_WOUT0)), MT, 1024, 1024}; pg8::StaticOrder S; S.init(MT, 1024, F.G, F.bid);
            pg8::EpiRes E{XB, nullptr, RS + (size_t)(3 * l + 2) * MT, 1.0f, 0};
            REP(2, dry) { E.dry = dry; pg8::gemm_phase<pg8::EpiRes, pg8::StaticOrder, true, true>(glds, g, S, E, F.tid); } }
        SEAM(pb + 5);
        if (KEN(1) && IN(pb + 6)) { LAUNDER(); pg8::Gemm g{XB, (const pg8::bf16_t*)(ws + WS_GU0 + (size_t)(2 * l + 1) * SZ_GU), MT, 5632, 1024}; pg8::StaticOrder S; S.init(MT, 5632, F.G, F.bid);
            pg8::EpiGU E{HB, FF, RS + (size_t)(3 * l + 2) * MT, 0};
            REP(1, dry) { E.dry = dry; pg8::gemm_phase<pg8::EpiGU, pg8::StaticOrder, true, true>(glds, g, S, E, F.tid); }
            if (F.G == 256 && F.bid >= 128) conv_items(F, l ? CV_T11 : CV_T3, l ? CV_ALL : CV_T7, (F.bid - 128) * NWAVES + F.wave, 128 * NWAVES); }
        SEAM(pb + 6);
        if (KEN(2) && IN(pb + 7)) { LAUNDER(); pg8::Gemm g{HB, (const pg8::bf16_t*)(ws + WS_DN0 + (size_t)(2 * l + 1) * SZ_DN), MT, 1024, FF}; pg8::StaticOrder S; S.init(MT, 1024, F.G, F.bid);
            pg8::EpiRes E{XB, l == 0 ? nullptr : outp, l == 0 ? RS + (size_t)3 * MT : nullptr, 0.5f, 0};
            REP(2, dry) { E.dry = dry; pg8::gemm_phase<pg8::EpiRes, pg8::StaticOrder, true, true>(glds, g, S, E, F.tid); } }
        if (l == 0) SEAM(pb + 7);
    }
#undef IN
#undef SEAM
#undef LAUNDER
#undef MYTID
}

extern "C" void kernel_launch(void* const* d_in, const int* in_sizes, int n_in, void* d_out, int out_size, void* d_ws, size_t ws_size, hipStream_t stream) {
    static int grid = 0;
    if (grid == 0) {
        if (n_in != 30 || out_size != MT * DM || ws_size < WS_END) { fprintf(stderr, "kernel_launch: unexpected shapes (n_in %d out %d ws %zu)\n", n_in, out_size, ws_size); grid = -1; return; }
        int dev = 0, cus = 0, per_cu = 0;
        hipGetDevice(&dev); hipDeviceGetAttribute(&cus, hipDeviceAttributeMultiprocessorCount, dev);
        hipFuncSetAttribute((const void*)mega_fwd, hipFuncAttributeMaxDynamicSharedMemorySize, LDS_BYTES);
        hipOccupancyMaxActiveBlocksPerMultiprocessor(&per_cu, (const void*)mega_fwd, NTHR, LDS_BYTES);
        if (per_cu < 1) { fprintf(stderr, "kernel_launch: occupancy query says %d blocks/CU\n", per_cu); grid = -1; return; }
        grid = cus;
        if (grid != 256) fprintf(stderr, "kernel_launch: note: %d CUs\n", grid);
    }
    if (grid < 0) return;
    hipMemsetAsync((char*)d_ws + WS_CTL, 0, CTL_ZERO_BYTES, stream);
    Args a{};
    for (int i = 0; i < 30; ++i) a.in[i] = (const float*)d_in[i];
    a.out = (float*)d_out; a.ws = (unsigned char*)d_ws;
#if MK_COOP
    a.ph_lo = 0; a.ph_hi = MK_STOP_AFTER; a.coop = 1;
    void* kargs[] = {&a};
    hipError_t e = hipLaunchCooperativeKernel((const void*)mega_fwd, dim3(grid), dim3(NTHR), kargs, LDS_BYTES, stream);
    if (e != hipSuccess) fprintf(stderr, "cooperative launch failed: %s\n", hipGetErrorString(e));
#else
    for (int p = 0; p < MK_STOP_AFTER; ++p) { a.ph_lo = p; a.ph_hi = p + 1; a.coop = 0;
        hipLaunchKernelGGL(mega_fwd, dim3(grid), dim3(NTHR), LDS_BYTES, stream, a); }
#endif
}
```
